# Optimizing an MI355X kernel written in HIP

```python
import math
import jax
import jax.numpy as jnp
from jax import lax
import numpy as np

D_MODEL = 2048
BATCH = 2
SEQ = 16384
DEPTH = 2
DEC_BATCH = 32
DEC_SEQ = 64
PAST_LEN = 4096

CHUNK = 64
N_EVEN = (DEPTH + 1) // 2
N_ODD = DEPTH // 2
D_FF = 5632
ALPHA = (2 * DEPTH) ** 0.25
BETA = (8 * DEPTH) ** -0.25
LN_EPS = 1e-5
RMS_EPS = 1e-6
POOL_WINDOWS = (2, 4, 8, 16)
POOL_GROUPS = len(POOL_WINDOWS)
POOL_CH = 384
POOL_WIDTH = POOL_GROUPS * POOL_CH
POOL_HIST = max(POOL_WINDOWS) - 1
SSM_WIDTH = D_MODEL - POOL_WIDTH
SSM_GROUP_CH = 16
SSM_GROUPS = SSM_WIDTH // SSM_GROUP_CH
SSM_STATE = 64
DT_MIN = 0.001
DT_MAX = 0.1
MLA_HEADS = 16
Q_LORA = 512
KV_LORA = 256
QK_NOPE = 64
QK_ROPE = 32
V_HEAD = 64
MLA_WIDTH = MLA_HEADS * V_HEAD
MLA_IN = Q_LORA + KV_LORA + QK_ROPE
ATTN_SCALE = (QK_NOPE + QK_ROPE) ** -0.5
ROPE_THETA = 10000.0
Q_BLOCK = 128
SG_CHUNK = 128
SG_GROUPS = 8
SG_WIDTH = D_MODEL - MLA_WIDTH
SG_CH = SG_WIDTH // SG_GROUPS
ODD_IN = MLA_IN + 2 * SG_WIDTH
NEG_INF = -1e30

kernel_name = 'hybrid_streaming_encoder_step'


def layer_norm(x, g, b):
    xf = x.astype(jnp.float32)
    mu = jnp.mean(xf, axis=-1, keepdims=True)
    var = jnp.mean(jnp.square(xf - mu), axis=-1, keepdims=True)
    return ((xf - mu) * lax.rsqrt(var + LN_EPS)).astype(x.dtype) * g + b


def rms_norm(x, g):
    xf = x.astype(jnp.float32)
    return (xf * lax.rsqrt(jnp.mean(xf * xf, axis=-1, keepdims=True) + RMS_EPS)).astype(x.dtype) * g


def swiglu_ffn(x, w1, w3, w2):
    return (jax.nn.silu(x @ w1) * (x @ w3)) @ w2


def rotary(x, pos):
    half = QK_ROPE // 2
    inv = ROPE_THETA ** (-jnp.arange(half, dtype=jnp.float32) / half)
    ang = pos.astype(jnp.float32)[:, None] * inv[None, :]
    shape = (1, x.shape[1]) + (1,) * (x.ndim - 3) + (half,)
    cos = jnp.cos(ang).reshape(shape)
    sin = jnp.sin(ang).reshape(shape)
    xf = x.astype(jnp.float32)
    x1, x2 = xf[..., :half], xf[..., half:]
    return jnp.concatenate([x1 * cos - x2 * sin, x2 * cos + x1 * sin], axis=-1).astype(x.dtype)


def pool_mixer(u, hist, pos0, w_pool, pool_scale):
    nb, s, _ = u.shape
    full = jnp.concatenate([hist, u], axis=1)
    cs = jnp.cumsum(full.astype(jnp.float32), axis=1)
    cs = jnp.concatenate([jnp.zeros((nb, 1, POOL_WIDTH), jnp.float32), cs], axis=1)
    t = jnp.arange(s)
    means = []
    for g, w in enumerate(POOL_WINDOWS):
        sl = slice(g * POOL_CH, (g + 1) * POOL_CH)
        hi = cs[:, POOL_HIST + 1:POOL_HIST + 1 + s, sl]
        lo = cs[:, POOL_HIST + 1 - w:POOL_HIST + 1 - w + s, sl]
        cnt = jnp.minimum(pos0 + t + 1, w).astype(jnp.float32)
        means.append((hi - lo) / cnt[None, :, None])
    mean = jnp.stack(means, axis=2).astype(u.dtype)
    d = mean - u.reshape(nb, s, POOL_GROUPS, POOL_CH)
    out = jnp.einsum('bsgc,gcd->bsgd', d, w_pool) * pool_scale
    return out.reshape(nb, s, POOL_WIDTH), full[:, -POOL_HIST:]


def _ssm_combine(e1, e2):
    ar, ai, br, bi = e1
    cr, ci, dr, di = e2
    return (cr * ar - ci * ai, cr * ai + ci * ar,
            cr * br - ci * bi + dr, cr * bi + ci * br + di)


def s5_mixer(u, h_re, h_im, lam_re, lam_im, log_dt, b_re, b_im, c_re, c_im, d_skip, w_glu, b_glu):
    nb, s, _ = u.shape
    f32 = jnp.float32
    uf = u.astype(f32).reshape(nb, s, SSM_GROUPS, SSM_GROUP_CH)
    dt = jnp.exp(log_dt.astype(f32))[:, None]
    lr = lam_re.astype(f32)
    li = lam_im.astype(f32)
    mag = jnp.exp(lr * dt)
    ab_re = mag * jnp.cos(li * dt)
    ab_im = mag * jnp.sin(li * dt)
    den = lr * lr + li * li
    nr = ab_re - 1.0
    co_re = (nr * lr + ab_im * li) / den
    co_im = (ab_im * lr - nr * li) / den
    br = b_re.astype(f32)
    bi = b_im.astype(f32)
    bb_re = co_re[..., None] * br - co_im[..., None] * bi
    bb_im = co_re[..., None] * bi + co_im[..., None] * br
    bu_re = jnp.einsum('bsgc,gpc->bsgp', uf, bb_re)
    bu_im = jnp.einsum('bsgc,gpc->bsgp', uf, bb_im)
    if h_re is not None:
        hr = h_re.astype(f32)
        hi = h_im.astype(f32)
        bu_re = bu_re.at[:, 0].add(ab_re * hr - ab_im * hi)
        bu_im = bu_im.at[:, 0].add(ab_re * hi + ab_im * hr)
    a_re = jnp.broadcast_to(ab_re, bu_re.shape)
    a_im = jnp.broadcast_to(ab_im, bu_im.shape)
    _, _, x_re, x_im = lax.associative_scan(_ssm_combine, (a_re, a_im, bu_re, bu_im), axis=1)
    y = (jnp.einsum('bsgp,gcp->bsgc', x_re, c_re.astype(f32))
         - jnp.einsum('bsgp,gcp->bsgc', x_im, c_im.astype(f32))
         + d_skip.astype(f32).reshape(SSM_GROUPS, SSM_GROUP_CH) * uf)
    y = y.reshape(nb, s, SSM_WIDTH).astype(u.dtype)
    g = jax.nn.gelu(y)
    out = g * jax.nn.sigmoid(g @ w_glu + b_glu)
    return out, x_re[:, -1].astype(u.dtype), x_im[:, -1].astype(u.dtype)


def mla_project(z, pos, g_q, g_kv, w_uq):
    cq = z[..., :Q_LORA]
    ckv = z[..., Q_LORA:Q_LORA + KV_LORA]
    kpe = z[..., Q_LORA + KV_LORA:MLA_IN]
    q = jnp.einsum('bsr,rhd->bshd', rms_norm(cq, g_q), w_uq)
    q_nope = q[..., :QK_NOPE]
    q_pe = rotary(q[..., QK_NOPE:], pos)
    c_kv = rms_norm(ckv, g_kv)
    k_pe = rotary(kpe, pos)
    return q_nope, q_pe, c_kv, k_pe


def mla_attend_prompt(q_nope, q_pe, c_kv, k_pe, w_uk, w_uv):
    nb, s = q_nope.shape[:2]
    k_nope = jnp.einsum('btr,rhd->bthd', c_kv, w_uk)
    v = jnp.einsum('btr,rhd->bthd', c_kv, w_uv)
    key_chunk = jnp.arange(s) // CHUNK
    nblk = s // Q_BLOCK
    qn = q_nope.reshape(nb, nblk, Q_BLOCK, MLA_HEADS, QK_NOPE).transpose(1, 0, 2, 3, 4)
    qp = q_pe.reshape(nb, nblk, Q_BLOCK, MLA_HEADS, QK_ROPE).transpose(1, 0, 2, 3, 4)

    def block(args):
        qn_b, qp_b, i = args
        sc = (jnp.einsum('bqhd,bthd->bhqt', qn_b, k_nope)
              + jnp.einsum('bqhd,btd->bhqt', qp_b, k_pe)).astype(jnp.float32) * ATTN_SCALE
        q_chunk = (i * Q_BLOCK + jnp.arange(Q_BLOCK)) // CHUNK
        mask = key_chunk[None, :] <= q_chunk[:, None]
        p = jax.nn.softmax(jnp.where(mask, sc, NEG_INF), axis=-1).astype(v.dtype)
        return jnp.einsum('bhqt,bthd->bqhd', p, v)

    out = lax.map(block, (qn, qp, jnp.arange(nblk)))
    return out.transpose(1, 0, 2, 3, 4).reshape(nb, s, MLA_WIDTH)


def mla_attend_sample(q_nope, q_pe, c_all, kpe_all, q_pos, k_pos, w_uk, w_uv):
    nb, s = q_nope.shape[:2]
    q_lat = jnp.einsum('bshd,rhd->bshr', q_nope, w_uk)
    sc = (jnp.einsum('bshr,btr->bhst', q_lat, c_all)
          + jnp.einsum('bshd,btd->bhst', q_pe, kpe_all)).astype(jnp.float32) * ATTN_SCALE
    mask = (k_pos // CHUNK)[None, :] <= (q_pos // CHUNK)[:, None]
    p = jax.nn.softmax(jnp.where(mask, sc, NEG_INF), axis=-1).astype(c_all.dtype)
    o_lat = jnp.einsum('bhst,btr->bshr', p, c_all)
    out = jnp.einsum('bshr,rhd->bshd', o_lat, w_uv)
    return out.reshape(nb, s, MLA_WIDTH)


def sgu_mixer(z, g_v, b_v, w_s, b_s):
    nb, s, _ = z.shape
    u = z[..., :SG_WIDTH]
    v = layer_norm(z[..., SG_WIDTH:], g_v, b_v)
    L = min(s, SG_CHUNK)
    vc = v.reshape(nb, s // L, L, SG_GROUPS, SG_CH)
    w = w_s[:, :L, :L] * jnp.tril(jnp.ones((L, L), w_s.dtype))
    mixed = jnp.einsum('gts,bnsgc->bntgc', w, vc) + b_s[:, :L].T[None, None, :, :, None]
    return u * mixed.reshape(nb, s, SG_WIDTH), v


def trunk(x, past_len, pool_hist, ssm_re, ssm_im, ckv_cache, kpe_cache, P):
    nb, s, _ = x.shape
    pos = past_len + jnp.arange(s, dtype=jnp.int32)
    pools, sres, sims, ckvs, kpes, sgvs = [], [], [], [], [], []
    for layer in range(DEPTH):
        ffn1 = swiglu_ffn(x, P['ffn1_w1'][layer], P['ffn1_w3'][layer], P['ffn1_w2'][layer])
        x = layer_norm(ALPHA * x + 0.5 * ffn1, P['ln_g'][layer, 0], P['ln_b'][layer, 0])
        i = layer // 2
        if layer % 2 == 0:
            z = x @ P['w_in_e'][i]
            hist = jnp.zeros((nb, POOL_HIST, POOL_WIDTH), x.dtype) if pool_hist is None else pool_hist[i]
            a_out, new_hist = pool_mixer(z[..., :POOL_WIDTH], hist, past_len, P['pool_w'][i], P['pool_scale'][i])
            h_re = None if ssm_re is None else ssm_re[i]
            h_im = None if ssm_im is None else ssm_im[i]
            b_out, s_re, s_im = s5_mixer(z[..., POOL_WIDTH:], h_re, h_im, P['ssm_lam_re'][i], P['ssm_lam_im'][i],
                                         P['ssm_log_dt'][i], P['ssm_b_re'][i], P['ssm_b_im'][i], P['ssm_c_re'][i],
                                         P['ssm_c_im'][i], P['ssm_d'][i], P['ssm_w_glu'][i], P['ssm_b_glu'][i])
            mix = jnp.concatenate([a_out, b_out], axis=-1) @ P['w_out_e'][i]
            pools.append(new_hist)
            sres.append(s_re)
            sims.append(s_im)
        else:
            z = x @ P['w_in_o'][i]
            q_nope, q_pe, c_kv, k_pe = mla_project(z, pos, P['mla_g_q'][i], P['mla_g_kv'][i], P['mla_w_uq'][i])
            if ckv_cache is None:
                att = mla_attend_prompt(q_nope, q_pe, c_kv, k_pe, P['mla_w_uk'][i], P['mla_w_uv'][i])
            else:
                c_all = jnp.concatenate([ckv_cache[i], c_kv], axis=1)
                kpe_all = jnp.concatenate([kpe_cache[i], k_pe], axis=1)
                k_pos = jnp.arange(c_all.shape[1], dtype=jnp.int32)
                att = mla_attend_sample(q_nope, q_pe, c_all, kpe_all, pos, k_pos, P['mla_w_uk'][i], P['mla_w_uv'][i])
            sg_out, v_rows = sgu_mixer(z[..., MLA_IN:], P['sg_g_v'][i], P['sg_b_v'][i], P['sg_w_s'][i], P['sg_b_s'][i])
            mix = jnp.concatenate([att, sg_out], axis=-1) @ P['w_out_o'][i]
            ckvs.append(c_kv)
            kpes.append(k_pe)
            sgvs.append(v_rows)
        x = layer_norm(ALPHA * x + mix, P['ln_g'][layer, 1], P['ln_b'][layer, 1])
        ffn2 = swiglu_ffn(x, P['ffn2_w1'][layer], P['ffn2_w3'][layer], P['ffn2_w2'][layer])
        x = layer_norm(ALPHA * x + 0.5 * ffn2, P['ln_g'][layer, 2], P['ln_b'][layer, 2])
    return (x, jnp.stack(pools), jnp.stack(sres), jnp.stack(sims),
            jnp.stack(ckvs), jnp.stack(kpes), jnp.stack(sgvs))


def setup_inputs(seed: int = 0) -> dict:
    key = jax.random.key(seed)
    ks = iter(jax.random.split(key, 64))
    f32 = jnp.float32

    def nrm(shape, scale):
        return jax.random.normal(next(ks), shape, f32) * scale

    n_idx = jnp.arange(SSM_STATE, dtype=f32)
    inp = {}
    inp['x_prompt'] = nrm((BATCH, SEQ, D_MODEL), 1.0)
    inp['x_sample'] = nrm((DEC_BATCH, DEC_SEQ, D_MODEL), 1.0)
    inp['cache_pool'] = nrm((N_EVEN, DEC_BATCH, POOL_HIST, POOL_WIDTH), 1.0)
    inp['state_ssm_re'] = nrm((N_EVEN, DEC_BATCH, SSM_GROUPS, SSM_STATE), 0.1)
    inp['state_ssm_im'] = nrm((N_EVEN, DEC_BATCH, SSM_GROUPS, SSM_STATE), 0.1)
    inp['cache_ckv'] = nrm((N_ODD, DEC_BATCH, PAST_LEN, KV_LORA), 1.0)
    inp['cache_kpe'] = nrm((N_ODD, DEC_BATCH, PAST_LEN, QK_ROPE), 1.0)
    inp['ln_g'] = 1.0 + nrm((DEPTH, 3, D_MODEL), 0.02)
    inp['ln_b'] = nrm((DEPTH, 3, D_MODEL), 0.02)
    inp['ffn1_w1'] = nrm((DEPTH, D_MODEL, D_FF), D_MODEL ** -0.5)
    inp['ffn1_w3'] = nrm((DEPTH, D_MODEL, D_FF), D_MODEL ** -0.5)
    inp['ffn1_w2'] = nrm((DEPTH, D_FF, D_MODEL), BETA * D_FF ** -0.5)
    inp['ffn2_w1'] = nrm((DEPTH, D_MODEL, D_FF), D_MODEL ** -0.5)
    inp['ffn2_w3'] = nrm((DEPTH, D_MODEL, D_FF), D_MODEL ** -0.5)
    inp['ffn2_w2'] = nrm((DEPTH, D_FF, D_MODEL), BETA * D_FF ** -0.5)
    inp['w_in_e'] = nrm((N_EVEN, D_MODEL, POOL_WIDTH + SSM_WIDTH), D_MODEL ** -0.5)
    inp['pool_w'] = nrm((N_EVEN, POOL_GROUPS, POOL_CH, POOL_CH), POOL_CH ** -0.5)
    inp['pool_scale'] = 1.0 + nrm((N_EVEN, POOL_GROUPS, POOL_CH), 0.02)
    inp['ssm_lam_re'] = -0.5 + nrm((N_EVEN, SSM_GROUPS, SSM_STATE), 0.01)
    inp['ssm_lam_im'] = math.pi * n_idx + nrm((N_EVEN, SSM_GROUPS, SSM_STATE), 0.01)
    inp['ssm_log_dt'] = jax.random.uniform(next(ks), (N_EVEN, SSM_GROUPS), f32,
                                           minval=math.log(DT_MIN), maxval=math.log(DT_MAX))
    inp['ssm_b_re'] = nrm((N_EVEN, SSM_GROUPS, SSM_STATE, SSM_GROUP_CH), (2 * SSM_GROUP_CH) ** -0.5)
    inp['ssm_b_im'] = nrm((N_EVEN, SSM_GROUPS, SSM_STATE, SSM_GROUP_CH), (2 * SSM_GROUP_CH) ** -0.5)
    inp['ssm_c_re'] = nrm((N_EVEN, SSM_GROUPS, SSM_GROUP_CH, SSM_STATE), (2 * SSM_STATE) ** -0.5)
    inp['ssm_c_im'] = nrm((N_EVEN, SSM_GROUPS, SSM_GROUP_CH, SSM_STATE), (2 * SSM_STATE) ** -0.5)
    inp['ssm_d'] = nrm((N_EVEN, SSM_WIDTH), 1.0)
    inp['ssm_w_glu'] = nrm((N_EVEN, SSM_WIDTH, SSM_WIDTH), SSM_WIDTH ** -0.5)
    inp['ssm_b_glu'] = nrm((N_EVEN, SSM_WIDTH), 0.02)
    inp['w_out_e'] = nrm((N_EVEN, POOL_WIDTH + SSM_WIDTH, D_MODEL), BETA * D_MODEL ** -0.5)
    inp['w_in_o'] = nrm((N_ODD, D_MODEL, ODD_IN), D_MODEL ** -0.5)
    inp['mla_g_q'] = 1.0 + nrm((N_ODD, Q_LORA), 0.02)
    inp['mla_g_kv'] = 1.0 + nrm((N_ODD, KV_LORA), 0.02)
    inp['mla_w_uq'] = nrm((N_ODD, Q_LORA, MLA_HEADS, QK_NOPE + QK_ROPE), Q_LORA ** -0.5)
    inp['mla_w_uk'] = nrm((N_ODD, KV_LORA, MLA_HEADS, QK_NOPE), KV_LORA ** -0.5)
    inp['mla_w_uv'] = nrm((N_ODD, KV_LORA, MLA_HEADS, V_HEAD), BETA * KV_LORA ** -0.5)
    inp['sg_g_v'] = 1.0 + nrm((N_ODD, SG_WIDTH), 0.02)
    inp['sg_b_v'] = nrm((N_ODD, SG_WIDTH), 0.02)
    inp['sg_w_s'] = nrm((N_ODD, SG_GROUPS, SG_CHUNK, SG_CHUNK), 0.5 * SG_CHUNK ** -0.5)
    inp['sg_b_s'] = 1.0 + nrm((N_ODD, SG_GROUPS, SG_CHUNK), 0.02)
    inp['w_out_o'] = nrm((N_ODD, MLA_WIDTH + SG_WIDTH, D_MODEL), BETA * D_MODEL ** -0.5)
    return inp


def reference(x_prompt, x_sample, cache_pool, state_ssm_re, state_ssm_im, cache_ckv, cache_kpe,
              ln_g, ln_b, ffn1_w1, ffn1_w3, ffn1_w2, ffn2_w1, ffn2_w3, ffn2_w2,
              w_in_e, pool_w, pool_scale, ssm_lam_re, ssm_lam_im, ssm_log_dt, ssm_b_re, ssm_b_im,
              ssm_c_re, ssm_c_im, ssm_d, ssm_w_glu, ssm_b_glu, w_out_e,
              w_in_o, mla_g_q, mla_g_kv, mla_w_uq, mla_w_uk, mla_w_uv,
              sg_g_v, sg_b_v, sg_w_s, sg_b_s, w_out_o):
    P = dict(ln_g=ln_g, ln_b=ln_b, ffn1_w1=ffn1_w1, ffn1_w3=ffn1_w3, ffn1_w2=ffn1_w2,
             ffn2_w1=ffn2_w1, ffn2_w3=ffn2_w3, ffn2_w2=ffn2_w2,
             w_in_e=w_in_e, pool_w=pool_w, pool_scale=pool_scale, ssm_lam_re=ssm_lam_re,
             ssm_lam_im=ssm_lam_im, ssm_log_dt=ssm_log_dt, ssm_b_re=ssm_b_re, ssm_b_im=ssm_b_im,
             ssm_c_re=ssm_c_re, ssm_c_im=ssm_c_im, ssm_d=ssm_d, ssm_w_glu=ssm_w_glu,
             ssm_b_glu=ssm_b_glu, w_out_e=w_out_e,
             w_in_o=w_in_o, mla_g_q=mla_g_q, mla_g_kv=mla_g_kv, mla_w_uq=mla_w_uq,
             mla_w_uk=mla_w_uk, mla_w_uv=mla_w_uv, sg_g_v=sg_g_v, sg_b_v=sg_b_v,
             sg_w_s=sg_w_s, sg_b_s=sg_b_s, w_out_o=w_out_o)
    y_prompt, pool_p, sre_p, sim_p, ckv_p, kpe_p, _ = trunk(
        x_prompt, 0, None, None, None, None, None, P)
    past_len = cache_ckv.shape[2]
    y_sample, pool_s, sre_s, sim_s, ckv_s, kpe_s, sgv_s = trunk(
        x_sample, past_len, cache_pool, state_ssm_re, state_ssm_im, cache_ckv, cache_kpe, P)
    return (y_prompt, y_sample, pool_p, sre_p, sim_p, ckv_p, kpe_p,
            pool_s, sre_s, sim_s, ckv_s, kpe_s, sgv_s)
```

```cpp
#include <hip/hip_runtime.h>
#include <cstdio>
#include <cstdint>

#define LAS __attribute__((address_space(3)))
#define GAS __attribute__((address_space(1)))
typedef unsigned short bf16_t;
typedef short bf16x8 __attribute__((ext_vector_type(8)));
typedef short s16x4 __attribute__((ext_vector_type(4)));
typedef float f32x4 __attribute__((ext_vector_type(4)));
typedef float f32x16 __attribute__((ext_vector_type(16)));
typedef unsigned u32x4 __attribute__((ext_vector_type(4)));
typedef unsigned u32x2 __attribute__((ext_vector_type(2)));

constexpr int DM = 2048, SEQ = 16384, MP = 2 * SEQ, MS = 32 * 64, MT = MP + MS, FF = 5632;
constexpr float ALPHA = 1.4142135623730951f;
constexpr float LN_EPS = 1e-5f, RMS_EPS = 1e-6f;
constexpr float C2 = 0.10206207261596575f * 1.4426950408889634f;
constexpr int NW = 8;

constexpr size_t O_YP = 0, O_YS = 67108864, O_POOLP = 71303168, O_SREP = 71349248, O_SIMP = 71353344, O_CKVP = 71357440, O_KPEP = 79746048,
                 O_POOLS = 80794624, O_SRES = 81531904, O_SIMS = 81597440, O_CKVS = 81662976, O_KPES = 82187264, O_SGVS = 82252800;

constexpr size_t MiB = 1u << 20;
constexpr size_t WS_CTL = 0, CTL_ZERO_BYTES = 32768;
constexpr size_t WS_ROPE = 1 * MiB, WS_KTAB = 3 * MiB, WS_A64 = 5 * MiB;
constexpr size_t WS_WUP = 8 * MiB, WS_WDN = 184 * MiB;
constexpr size_t WS_WINE = 272 * MiB, WS_WOUTE = 280 * MiB, WS_WINO = 288 * MiB, WS_WOUTO = 300 * MiB, WS_WMIXS = 308 * MiB, WS_AEXPK = 328 * MiB, WS_AEXPV = 336 * MiB,
                 WS_WQLAT = 344 * MiB, WS_WPOOL = 348 * MiB, WS_WUQ = 350 * MiB, WS_WKV = 352 * MiB, WS_WUQN = 353 * MiB, WS_WGLU = 354 * MiB, WS_WSG = 355 * MiB;
constexpr size_t WS_BT1 = 356 * MiB, WS_BT2 = 372 * MiB;
constexpr size_t WS_XB = 444 * MiB;
constexpr size_t WS_SCR = 580 * MiB;
constexpr size_t WS_H = WS_SCR;
constexpr size_t WS_ZP = 580 * MiB, WS_DP = 682 * MiB, WS_UP = 784 * MiB, WS_S1 = 838 * MiB, WS_GACT = 850 * MiB;
constexpr size_t WS_ZQ = 580 * MiB, WS_ZC = 648 * MiB, WS_ZK = 682 * MiB, WS_UB = 688 * MiB, WS_VPRE = 756 * MiB, WS_VB = 824 * MiB, WS_CQN = 892 * MiB, WS_CKVB = 926 * MiB,
                 WS_KPEB = 942 * MiB, WS_AS = 756 * MiB;
constexpr size_t WS_HISTB = 886 * MiB;
constexpr size_t WS_PART = 954 * MiB;
constexpr size_t WS_KP = 580 * MiB;
constexpr size_t WS_QP = 8 * MiB, WS_QS = 104 * MiB, WS_VP = 184 * MiB, WS_KXS = 356 * MiB;
constexpr size_t WS_END = 1024 * MiB;

constexpr int CW_TMO = 0, CW_BAR = 4096;
constexpr int LDS_BYTES = 147456, LDSCTL_OFF = 147456 - 256;

__device__ __forceinline__ unsigned f2bf(float f) { unsigned u = __builtin_bit_cast(unsigned, f); return (u + 0x7fffu + ((u >> 16) & 1u)) >> 16; }
typedef float f32x2_t __attribute__((ext_vector_type(2))); typedef __bf16 bf16x2_t __attribute__((ext_vector_type(2)));
__device__ __forceinline__ unsigned pk2(float lo, float hi) { const f32x2_t v = {lo, hi}; const bf16x2_t b = __builtin_convertvector(v, bf16x2_t); return __builtin_bit_cast(unsigned, b); }
__device__ __forceinline__ float bf2f(unsigned short u) { return __builtin_bit_cast(float, (unsigned)u << 16); }
__device__ __forceinline__ float bflo(unsigned w) { return __builtin_bit_cast(float, w << 16); }
__device__ __forceinline__ float bfhi(unsigned w) { return __builtin_bit_cast(float, w & 0xffff0000u); }
__device__ __forceinline__ void half_swap(float x, float& lo, float& hi) {
    unsigned a = __builtin_bit_cast(unsigned, x), b = a;
    asm volatile("s_nop 1\n\tv_permlane32_swap_b32 %0, %1\n\ts_nop 1" : "+v"(a), "+v"(b));
    lo = __builtin_bit_cast(float, a); hi = __builtin_bit_cast(float, b);
}
#define DPP_ADD(v, ctrl) v += __builtin_bit_cast(float, __builtin_amdgcn_update_dpp(0, __builtin_bit_cast(int, v), ctrl, 0xf, 0xf, false))
__device__ __forceinline__ float wave_sum(float v) {
    DPP_ADD(v, 0xB1); DPP_ADD(v, 0x4E); DPP_ADD(v, 0x141); DPP_ADD(v, 0x140);
    v += __builtin_bit_cast(float, __builtin_amdgcn_ds_swizzle(__builtin_bit_cast(int, v), (16 << 10) | 0x1f));
    float lo, hi; half_swap(v, lo, hi); return lo + hi;
}
__device__ __forceinline__ float ex2(float x) { return __builtin_amdgcn_exp2f(x); }
__device__ __forceinline__ float sigmoidf_(float x) { return __builtin_amdgcn_rcpf(1.f + ex2(-1.4426950408889634f * x)); }
__device__ __forceinline__ float siluf_(float x) { return x * sigmoidf_(x); }
__device__ __forceinline__ float gelu_tanh(float y) { const float z = 0.7978845608028654f * (y + 0.044715f * y * y * y); const float t = 1.f - 2.f * __builtin_amdgcn_rcpf(1.f + ex2(2.885390081777927f * z)); return 0.5f * y * (1.f + t); }
__device__ __forceinline__ u32x4 pack8(f32x4 a, f32x4 b) { u32x4 w; w.x = pk2(a[0], a[1]); w.y = pk2(a[2], a[3]); w.z = pk2(b[0], b[1]); w.w = pk2(b[2], b[3]); return w; }
__device__ __forceinline__ void dsincos(double x, double& s, double& c) {
    const double k = rint(x * 0.6366197723675814); const double y = x - k * 1.5707963267948966192;
    const double y2 = y * y;
    const double sy = y * (1.0 + y2 * (-1.0 / 6 + y2 * (1.0 / 120 + y2 * (-1.0 / 5040 + y2 * (1.0 / 362880 + y2 * (-1.0 / 39916800 + y2 * (1.0 / 6227020800.0)))))));
    const double cy = 1.0 + y2 * (-0.5 + y2 * (1.0 / 24 + y2 * (-1.0 / 720 + y2 * (1.0 / 40320 + y2 * (-1.0 / 3628800 + y2 * (1.0 / 479001600.0))))));
    const int q = ((int)(long long)k) & 3;
    s = (q == 0) ? sy : (q == 1) ? cy : (q == 2) ? -sy : -cy;
    c = (q == 0) ? cy : (q == 1) ? -sy : (q == 2) ? -cy : sy;
}
__device__ __forceinline__ double dexp(double x) {
    const double n = rint(x * 1.4426950408889634); const double r = x - n * 0.6931471805599453094;
    double p = 1.0 / 479001600.0;
    p = p * r + 1.0 / 39916800; p = p * r + 1.0 / 3628800; p = p * r + 1.0 / 362880; p = p * r + 1.0 / 40320; p = p * r + 1.0 / 5040; p = p * r + 1.0 / 720;
    p = p * r + 1.0 / 120; p = p * r + 1.0 / 24; p = p * r + 1.0 / 6; p = p * r + 0.5; p = p * r + 1.0; p = p * r + 1.0;
    return ldexp(p, (int)n);
}

namespace pg8 {
constexpr int BM = 256, BK = 64, HALF = 128, HTB = HALF * BK * 2, NXCD = 8, WGM = 8;
__host__ __device__ __forceinline__ int lds_byte(int r, int c) { const int st = (r >> 4) * 2 + (c >> 5), rr = r & 15, cc = c & 31, ob = rr * 64 + cc * 2; return st * 1024 + (ob ^ (((ob >> 9) & 1) << 5)); }
__host__ __device__ __forceinline__ void stage_rc(int b, int& R, int& C) { const int st = b / 1024, sb = b % 1024, swz = sb ^ (((sb >> 9) & 1) << 5); R = (st >> 1) * 16 + swz / 64; C = (st & 1) * 32 + (swz % 64) / 2; }
__host__ __device__ __forceinline__ int perm32(int rho) { const int n = rho >> 4, i = rho & 15; return 8 * (i >> 2) + 4 * n + (i & 3); }

struct Unit { int pm, pn, g, lm, ln, kofs, nt; };
struct Gemm { const bf16_t* A; const bf16_t* Bt; int K, lda, ldb; };

struct TileOrder {
    int nM, nN, nwg, G, c, pm0, pn0;
    __device__ __forceinline__ void init(int nM_, int nN_, int G_, int c_, int pm0_ = 0, int pn0_ = 0) { nM = nM_; nN = nN_; nwg = nM * nN; G = G_; c = c_; pm0 = pm0_; pn0 = pn0_; }
    __device__ __forceinline__ bool next(int i, Unit& u) const {
        const long L = (long)i * G + c; if (L >= nwg) return false;
        int wgid = (int)L; { const int q = nwg / NXCD, r = nwg % NXCD, xcd = wgid % NXCD, off = wgid / NXCD; wgid = (xcd < r ? xcd * (q + 1) : r * (q + 1) + (xcd - r) * q) + off; }
        const int nig = WGM * nN, gid = wgid / nig, fm = gid * WGM, gsz = (nM - fm) < WGM ? (nM - fm) : WGM;
        const int pm = fm + ((wgid % nig) % gsz), pn = (wgid % nig) / gsz;
        u.pm = pm0 + pm; u.pn = pn0 + pn; u.g = 0; u.lm = pm; u.ln = pn; u.kofs = 0; u.nt = 0; return true;
    }
    __device__ __forceinline__ void a_ready(const Unit&) const {}
    __device__ __forceinline__ void done(const Unit&) const {}
};
struct SplitOrder {
    TileOrder T; int nfull, nsplit, nN, pms0, ntq, G, c;
    __device__ __forceinline__ void init(int nMf, int nMs, int nN_, int pms0_, int ntq_, int G_, int c_) { T.init(nMf, nN_, G_, c_); nfull = nMf * nN_; nsplit = nMs * nN_ * 4; nN = nN_; pms0 = pms0_; ntq = ntq_; G = G_; c = c_; }
    __device__ __forceinline__ bool next(int i, Unit& u) const {
        const long L = (long)i * G + c;
        if (L < nfull) return T.next(i, u);
        const int s_ = (int)(L - nfull); if (s_ >= nsplit) return false;
        const int kq = s_ & 3, tile = s_ >> 2, pm = tile / nN, pn = tile - pm * nN;
        u.pm = pms0 + pm; u.pn = pn; u.g = kq; u.lm = pm; u.ln = pn; u.kofs = kq * ntq * 64; u.nt = ntq; return true;
    }
    __device__ __forceinline__ void a_ready(const Unit&) const {}
    __device__ __forceinline__ void done(const Unit&) const {}
};
struct S5Order {
    int c;
    __device__ __forceinline__ void init(int c_) { c = c_; }
    __device__ __forceinline__ bool next(int i, Unit& u) const {
        int q, ln;
        if (c < 96) { if (i > 0) return false; q = c; ln = 3; }
        else if (c < 192) { if (i > 1) return false; q = c - 96; ln = i == 0 ? 2 : 0; }
        else if (c < 240) { if (i > 1) return false; q = 2 * (c - 192) + i; ln = 1; }
        else return false;
        const int g = q / 3, lm = q - 3 * g;
        u.pm = g * 3 + lm; u.pn = g * 4 + ln; u.g = g; u.lm = lm; u.ln = ln; u.kofs = 768 - 256 * ln; u.nt = 6 + 4 * ln; return true;
    }
    __device__ __forceinline__ void a_ready(const Unit&) const {}
    __device__ __forceinline__ void done(const Unit&) const {}
};
struct GroupOrder {
    int nMg, nNg, per, total, G, c, sA, sB;
    __device__ __forceinline__ void init(int ng, int nMg_, int nNg_, int sA_, int sB_, int G_, int c_) { nMg = nMg_; nNg = nNg_; per = nMg * nNg; total = ng * per; sA = sA_; sB = sB_; G = G_; c = c_; }
    __device__ __forceinline__ bool next(int i, Unit& u) const {
        const long L = (long)i * G + c; if (L >= total) return false;
        const int g = (int)L / per, r = (int)L % per, lm = r / nNg, ln = r % nNg;
        u.pm = g * sA + lm; u.pn = g * sB + ln; u.g = g; u.lm = lm; u.ln = ln; u.kofs = 0; u.nt = 0; return true;
    }
    __device__ __forceinline__ void a_ready(const Unit&) const {}
    __device__ __forceinline__ void done(const Unit&) const {}
};

template <class Epi, class Sched>
__device__ __forceinline__ void gemm_phase(LAS unsigned char* lds, const Gemm g, const Sched& S, const Epi& E) {
    int tid_ = threadIdx.x; asm volatile("" : "+v"(tid_));
    const int tid = tid_, wid = __builtin_amdgcn_readfirstlane(tid >> 6), lane = tid & 63, wr = wid >> 2, wc = wid & 3, fr = lane & 15, fq = lane >> 4;
    int K_ = g.K; asm volatile("" : "+s"(K_)); const int K = K_, nt = K / BK;
    unsigned voffA[2], voffB[2];
#pragma unroll
    for (int i = 0; i < 2; ++i) { int R, C; stage_rc(tid * 16 + i * 8192, R, C); const int Rb = Epi::PERM ? ((R & ~31) + perm32(R & 31)) : R;
        voffA[i] = (unsigned)(R * g.lda + C) * 2u; voffB[i] = (unsigned)(Rb * g.ldb + C) * 2u; }
    const size_t kstep = (size_t)(BK * 2);
    const size_t hstepA = (size_t)HALF * g.lda * 2, hstepB = (size_t)HALF * g.ldb * 2;
    const size_t tstepA = 2 * hstepA, tstepB = 2 * hstepB;
    const unsigned ldsw = (unsigned)wid * 1024u;
    const int aoff = lds_byte(wr * 64 + fr, fq * 8), boff = lds_byte(wc * 32 + fr, fq * 8);
#define PG8_SA(b, h) (((b) * 2 + (h)) * HTB)
#define PG8_SB(b, h) ((4 + (b) * 2 + (h)) * HTB)
#define PG8_STAGE(bufoff, gbase, voff) do { _Pragma("unroll") for (int _i = 0; _i < 2; ++_i) \
        __builtin_amdgcn_global_load_lds((const unsigned*)((const char*)(gbase) + (voff)[_i]), (LAS unsigned*)(lds + (bufoff) + ldsw + _i * 8192), 16, 0, 0); } while (0)
#define PG8_LDA(dst, b, h) do { _Pragma("unroll") for (int m = 0; m < 4; ++m) _Pragma("unroll") for (int k = 0; k < 2; ++k) dst[m][k] = *(const LAS bf16x8*)(lds + PG8_SA(b, h) + aoff + m * 2048 + k * 1024); } while (0)
#define PG8_LDB(dst, b, h) do { _Pragma("unroll") for (int n = 0; n < 2; ++n) _Pragma("unroll") for (int k = 0; k < 2; ++k) dst[n][k] = *(const LAS bf16x8*)(lds + PG8_SB(b, h) + boff + n * 2048 + k * 1024); } while (0)
#define PG8_MMA(ai, bj, At, Bt) do { __builtin_amdgcn_s_setprio(1); _Pragma("unroll") for (int m = 0; m < 4; ++m) _Pragma("unroll") for (int n = 0; n < 2; ++n) _Pragma("unroll") for (int k = 0; k < 2; ++k) \
        acc[ai][bj][m][n] = __builtin_amdgcn_mfma_f32_16x16x32_bf16(Bt[n][k], At[m][k], acc[ai][bj][m][n], 0, 0, 0); __builtin_amdgcn_s_setprio(0); } while (0)
#define PG8_WAIT_V(n) asm volatile("s_waitcnt vmcnt(" #n ")" ::: "memory")
#define PG8_WAIT_L(n) asm volatile("s_waitcnt lgkmcnt(" #n ")" ::: "memory")
#define PG8_BAR __builtin_amdgcn_s_barrier()
#define PG8_SCHED __builtin_amdgcn_sched_barrier(0)
    Unit cur, nxt; int ui = 0;
    if (!S.next(0, cur)) return;
    f32x4 acc[2][2][4][2];
#pragma unroll
    for (int a = 0; a < 2; ++a)
#pragma unroll
        for (int b = 0; b < 2; ++b)
#pragma unroll
            for (int m = 0; m < 4; ++m)
#pragma unroll
                for (int n = 0; n < 2; ++n) acc[a][b][m][n] = (f32x4){0.f, 0.f, 0.f, 0.f};
    bf16x8 At[4][2], B0[2][2], B1[2][2];
    const char* cA = (const char*)g.A + (size_t)cur.pm * tstepA + (size_t)cur.kofs * 2; const char* cB = (const char*)g.Bt + (size_t)cur.pn * tstepB + (size_t)cur.kofs * 2;
    S.a_ready(cur);
    PG8_STAGE(PG8_SB(0, 0), cB, voffB); PG8_STAGE(PG8_SB(0, 1), cB + hstepB, voffB); PG8_STAGE(PG8_SA(0, 0), cA, voffA); PG8_STAGE(PG8_SA(0, 1), cA + hstepA, voffA);
    if (wr == 1) PG8_BAR;
    PG8_WAIT_V(2); PG8_BAR;
    PG8_STAGE(PG8_SB(1, 0), cB + kstep, voffB); PG8_STAGE(PG8_SA(1, 0), cA + kstep, voffA); PG8_STAGE(PG8_SB(1, 1), cB + hstepB + kstep, voffB);
    PG8_WAIT_V(6); PG8_BAR;
    for (;;) {
        const bool has_next = S.next(ui + 1, nxt);
        const char* nA = has_next ? (const char*)g.A + (size_t)nxt.pm * tstepA + (size_t)nxt.kofs * 2 : cA; const char* nB = has_next ? (const char*)g.Bt + (size_t)nxt.pn * tstepB + (size_t)nxt.kofs * 2 : cB;
        const int ntc = cur.nt ? cur.nt : nt;
#pragma clang loop unroll(disable)
        for (int t = 0; t < ntc; t += 2) {
            const bool last = (t == ntc - 2);
            const char* a1 = cA + (size_t)(t + 1) * kstep;
            const char* a2 = last ? nA : cA + (size_t)(t + 2) * kstep; const char* b2 = last ? nB : cB + (size_t)(t + 2) * kstep;
            const char* a3 = a2 + kstep; const char* b3 = b2 + kstep;
            if (last && has_next) S.a_ready(nxt);
            PG8_LDB(B0, 0, 0); PG8_LDB(B1, 0, 1); PG8_SCHED; PG8_LDA(At, 0, 0); PG8_STAGE(PG8_SA(1, 1), a1 + hstepA, voffA);
            PG8_WAIT_V(8); PG8_WAIT_L(0); PG8_BAR; PG8_MMA(0, 0, At, B0); PG8_MMA(0, 1, At, B1); PG8_BAR; PG8_SCHED;
            PG8_LDA(At, 0, 1); PG8_STAGE(PG8_SB(0, 0), b2, voffB); PG8_STAGE(PG8_SB(0, 1), b2 + hstepB, voffB); PG8_STAGE(PG8_SA(0, 0), a2, voffA);
            PG8_WAIT_V(8); PG8_WAIT_L(0); PG8_BAR; PG8_MMA(1, 0, At, B0); PG8_MMA(1, 1, At, B1); PG8_BAR; PG8_SCHED;
            PG8_LDB(B0, 1, 0); PG8_LDB(B1, 1, 1); PG8_SCHED; PG8_LDA(At, 1, 0); PG8_STAGE(PG8_SA(0, 1), a2 + hstepA, voffA);
            PG8_WAIT_V(8); PG8_WAIT_L(0); PG8_BAR; PG8_MMA(0, 0, At, B0); PG8_MMA(0, 1, At, B1); PG8_BAR; PG8_SCHED;
            PG8_LDA(At, 1, 1); PG8_STAGE(PG8_SB(1, 0), b3, voffB); PG8_STAGE(PG8_SB(1, 1), b3 + hstepB, voffB); PG8_STAGE(PG8_SA(1, 0), a3, voffA);
            PG8_WAIT_V(8); PG8_WAIT_L(0); PG8_BAR; PG8_MMA(1, 0, At, B0); PG8_MMA(1, 1, At, B1); PG8_BAR; PG8_SCHED;
        }
        if (wr == 0) PG8_BAR;
        E(acc, cur, wr, wc, fr, fq); S.done(cur);
        if (!has_next) break;
#pragma unroll
        for (int a = 0; a < 2; ++a)
#pragma unroll
            for (int b = 0; b < 2; ++b)
#pragma unroll
                for (int m = 0; m < 4; ++m)
#pragma unroll
                    for (int n = 0; n < 2; ++n) acc[a][b][m][n] = (f32x4){0.f, 0.f, 0.f, 0.f};
        cur = nxt; cA = nA; cB = nB; ++ui;
        if (wr == 1) PG8_BAR;
    }
    PG8_WAIT_V(0);
    PG8_BAR;
#undef PG8_SA
#undef PG8_SB
#undef PG8_STAGE
#undef PG8_LDA
#undef PG8_LDB
#undef PG8_MMA
#undef PG8_WAIT_V
#undef PG8_WAIT_L
#undef PG8_BAR
#undef PG8_SCHED
}

typedef const f32x4 (&AccRef)[2][2][4][2];

struct EpiSwiglu { static constexpr bool PERM = true; bf16_t* H;
    __device__ __forceinline__ void operator()(AccRef acc, const Unit& u, int wr, int wc, int fr, int fq) const {
        const int row0 = u.pm * 256 + wr * 64 + fr, col0 = u.pn * 128 + wc * 32 + 8 * fq;
#pragma unroll
        for (int ai = 0; ai < 2; ++ai)
#pragma unroll
            for (int m = 0; m < 4; ++m) { bf16_t* rowp = H + (size_t)(row0 + ai * 128 + m * 16) * FF + col0;
                f32x4 h0, h1;
#pragma unroll
                for (int e = 0; e < 4; ++e) { h0[e] = siluf_(acc[ai][0][m][0][e]) * acc[ai][1][m][0][e]; h1[e] = siluf_(acc[ai][0][m][1][e]) * acc[ai][1][m][1][e]; }
                *(u32x4*)rowp = pack8(h0, h1); }
    }
};
struct EpiResid { static constexpr bool PERM = true; const bf16_t* xsrc; bf16_t* tdst; float scale; int row_off; float* part;
    __device__ __forceinline__ void operator()(AccRef acc, const Unit& u, int wr, int wc, int fr, int fq) const {
        const int row0 = row_off + u.pm * 256 + wr * 64 + fr, col0 = u.pn * 256 + wc * 32 + 8 * fq;
        if (u.nt) {
#pragma unroll
            for (int ai = 0; ai < 2; ++ai)
#pragma unroll
                for (int m = 0; m < 4; ++m) { float* pp = part + ((size_t)u.g * MS + (row0 + ai * 128 + m * 16 - MP)) * DM + col0;
#pragma unroll
                    for (int bj = 0; bj < 2; ++bj) { *(f32x4*)(pp + bj * 128) = acc[ai][bj][m][0]; *(f32x4*)(pp + bj * 128 + 4) = acc[ai][bj][m][1]; } }
        } else {
#pragma unroll
            for (int ai = 0; ai < 2; ++ai)
#pragma unroll
                for (int m = 0; m < 4; ++m) { const size_t ro = (size_t)(row0 + ai * 128 + m * 16) * DM + col0;
#pragma unroll
                    for (int bj = 0; bj < 2; ++bj) { const u32x4 xw = *(const u32x4*)(xsrc + ro + bj * 128);
                        const f32x4 x0 = (f32x4){bflo(xw.x), bfhi(xw.x), bflo(xw.y), bfhi(xw.y)}, x1 = (f32x4){bflo(xw.z), bfhi(xw.z), bflo(xw.w), bfhi(xw.w)};
                        *(u32x4*)(tdst + ro + bj * 128) = pack8(x0 * ALPHA + acc[ai][bj][m][0] * scale, x1 * ALPHA + acc[ai][bj][m][1] * scale); } }
        }
    }
};
struct EpiZe { static constexpr bool PERM = true; bf16_t* ZP; bf16_t* UP; float* out;
    __device__ __forceinline__ void operator()(AccRef acc, const Unit& u, int wr, int wc, int fr, int fq) const {
        const int row0 = u.pm * 256 + wr * 64 + fr, col0 = u.pn * 256 + wc * 32 + 8 * fq;
#pragma unroll
        for (int ai = 0; ai < 2; ++ai)
#pragma unroll
            for (int m = 0; m < 4; ++m) { const int row = row0 + ai * 128 + m * 16;
#pragma unroll
                for (int bj = 0; bj < 2; ++bj) { const int col = col0 + bj * 128; const f32x4 v0 = acc[ai][bj][m][0], v1 = acc[ai][bj][m][1];
                    if (u.pn < 6) {
                        *(u32x4*)(ZP + (size_t)row * 1536 + col) = pack8(v0, v1);
                        float* op = nullptr;
                        if (row < MP) { const int t = row & (SEQ - 1); if (t >= SEQ - 15) op = out + O_POOLP + ((size_t)((row >> 14) * 15 + (t - (SEQ - 15))) * 1536 + col); }
                        else { const int rs = row - MP, t = rs & 63; if (t >= 49) op = out + O_POOLS + ((size_t)((rs >> 6) * 15 + (t - 49)) * 1536 + col); }
                        if (op) { *(f32x4*)op = v0; *(f32x4*)(op + 4) = v1; }
                    } else {
                        const int cs = col - 1536, g = cs >> 4, c8 = cs & 15;
                        const int chunkrow = row < MP ? (row >> 6) : 512 + ((row - MP) >> 6), i = row & 63;
                        *(u32x4*)(UP + ((size_t)g * 768 + chunkrow) * 1152 + (63 - i) * 16 + c8) = pack8(v0, v1);
                    } } }
    }
};
struct EpiS1 { static constexpr bool PERM = false; float* S1;
    __device__ __forceinline__ void operator()(AccRef acc, const Unit& u, int wr, int wc, int fr, int fq) const {
        const int row0 = u.lm * 256 + wr * 64 + fr, col0 = wc * 32 + 4 * fq;
#pragma unroll
        for (int ai = 0; ai < 2; ++ai)
#pragma unroll
            for (int m = 0; m < 4; ++m) { float* rp = S1 + ((size_t)u.g * 768 + row0 + ai * 128 + m * 16) * 128 + col0;
#pragma unroll
                for (int n = 0; n < 2; ++n) *(f32x4*)(rp + n * 16) = acc[ai][0][m][n]; }
    }
};
struct EpiPool { static constexpr bool PERM = true; bf16_t* MIX; const float* pscale;
    __device__ __forceinline__ void operator()(AccRef acc, const Unit& u, int wr, int wc, int fr, int fq) const {
        const int row0 = u.lm * 256 + wr * 64 + fr, col0 = u.ln * 256 + wc * 32 + 8 * fq;
#pragma unroll
        for (int bj = 0; bj < 2; ++bj) { const int col = col0 + bj * 128;
            if (col < 384) { const f32x4 s0 = *(const f32x4*)(pscale + u.g * 384 + col), s1 = *(const f32x4*)(pscale + u.g * 384 + col + 4);
#pragma unroll
                for (int ai = 0; ai < 2; ++ai)
#pragma unroll
                    for (int m = 0; m < 4; ++m) *(u32x4*)(MIX + (size_t)(row0 + ai * 128 + m * 16) * DM + u.g * 384 + col) = pack8(acc[ai][bj][m][0] * s0, acc[ai][bj][m][1] * s1); } }
    }
};
struct EpiS2 { static constexpr bool PERM = true; bf16_t* GACT;
    __device__ __forceinline__ void operator()(AccRef acc, const Unit& u, int wr, int wc, int fr, int fq) const {
        const int row0 = u.lm * 256 + wr * 64 + fr, col0 = u.ln * 256 + wc * 32 + 8 * fq;
#pragma unroll
        for (int ai = 0; ai < 2; ++ai)
#pragma unroll
            for (int m = 0; m < 4; ++m) { const int rl = row0 + ai * 128 + m * 16;
                if (rl < 544) {
#pragma unroll
                    for (int bj = 0; bj < 2; ++bj) { const int col = col0 + bj * 128, j = col >> 4, c8 = col & 15;
                        const int tok = rl < 512 ? rl * 64 + j : MP + (rl - 512) * 64 + j;
                        f32x4 a = acc[ai][bj][m][0], b = acc[ai][bj][m][1];
#pragma unroll
                        for (int e = 0; e < 4; ++e) { a[e] = gelu_tanh(a[e]); b[e] = gelu_tanh(b[e]); }
                        *(u32x4*)(GACT + (size_t)tok * 512 + u.g * 16 + c8) = pack8(a, b); } } }
    }
};
struct EpiGlu { static constexpr bool PERM = true; const bf16_t* GACT; const float* bglu; bf16_t* MIX;
    __device__ __forceinline__ void operator()(AccRef acc, const Unit& u, int wr, int wc, int fr, int fq) const {
        const int row0 = u.pm * 256 + wr * 64 + fr, col0 = u.pn * 256 + wc * 32 + 8 * fq;
#pragma unroll
        for (int bj = 0; bj < 2; ++bj) { const int col = col0 + bj * 128; const f32x4 b0 = *(const f32x4*)(bglu + col), b1 = *(const f32x4*)(bglu + col + 4);
#pragma unroll
            for (int ai = 0; ai < 2; ++ai)
#pragma unroll
                for (int m = 0; m < 4; ++m) { const int row = row0 + ai * 128 + m * 16; const u32x4 gw = *(const u32x4*)(GACT + (size_t)row * 512 + col);
                    const f32x4 g0 = (f32x4){bflo(gw.x), bfhi(gw.x), bflo(gw.y), bfhi(gw.y)}, g1 = (f32x4){bflo(gw.z), bfhi(gw.z), bflo(gw.w), bfhi(gw.w)};
                    f32x4 o0, o1;
#pragma unroll
                    for (int e = 0; e < 4; ++e) { o0[e] = g0[e] * sigmoidf_(acc[ai][bj][m][0][e] + b0[e]); o1[e] = g1[e] * sigmoidf_(acc[ai][bj][m][1][e] + b1[e]); }
                    *(u32x4*)(MIX + (size_t)row * DM + 1536 + col) = pack8(o0, o1); } }
    }
};
struct EpiZo { static constexpr bool PERM = true; float* ZQ; float* ZC; float* ZK; bf16_t* UB; bf16_t* VPRE;
    __device__ __forceinline__ void operator()(AccRef acc, const Unit& u, int wr, int wc, int fr, int fq) const {
        const int row0 = u.pm * 256 + wr * 64 + fr, cl0 = wc * 32 + 8 * fq;
#pragma unroll
        for (int ai = 0; ai < 2; ++ai)
#pragma unroll
            for (int m = 0; m < 4; ++m) { const size_t row = (size_t)(row0 + ai * 128 + m * 16);
#pragma unroll
                for (int bj = 0; bj < 2; ++bj) { const int cl = cl0 + bj * 128; const f32x4 v0 = acc[ai][bj][m][0], v1 = acc[ai][bj][m][1];
                    if (u.pn < 2) { float* p = ZQ + row * 512 + u.pn * 256 + cl; *(f32x4*)p = v0; *(f32x4*)(p + 4) = v1; }
                    else if (u.pn == 2) { float* p = ZC + row * 256 + cl; *(f32x4*)p = v0; *(f32x4*)(p + 4) = v1; }
                    else if (u.pn < 7) *(u32x4*)(UB + row * 1024 + (u.pn - 3) * 256 + cl) = pack8(v0, v1);
                    else if (u.pn < 11) *(u32x4*)(VPRE + row * 1024 + (u.pn - 7) * 256 + cl) = pack8(v0, v1);
                    else if (cl < 32) { float* p = ZK + row * 32 + cl; *(f32x4*)p = v0; *(f32x4*)(p + 4) = v1; } } }
    }
};
struct EpiQ { static constexpr bool PERM = true; bf16_t* QP; bf16_t* QS; const float* rope;
    __device__ __forceinline__ void operator()(AccRef acc, const Unit& u, int wr, int wc, int fr, int fq) const {
        const int row0 = u.pm * 256 + wr * 64 + fr;
#pragma unroll
        for (int ai = 0; ai < 2; ++ai)
#pragma unroll
            for (int m = 0; m < 4; ++m) { const int row = row0 + ai * 128 + m * 16;
                if (u.pn < 4) {
#pragma unroll
                    for (int bj = 0; bj < 2; ++bj) { const int col = u.pn * 256 + bj * 128 + wc * 32 + 8 * fq, h = col >> 6, d = col & 63;
                        *(u32x4*)(QP + (size_t)row * 1536 + h * 96 + d) = pack8(acc[ai][bj][m][0] * C2, acc[ai][bj][m][1] * C2); }
                } else {
                    const int pos = row < MP ? (row & (SEQ - 1)) : 4096 + ((row - MP) & 63);
                    const f32x4 cs = *(const f32x4*)(rope + (size_t)pos * 32 + 4 * fq), sn = *(const f32x4*)(rope + (size_t)pos * 32 + 16 + 4 * fq);
#pragma unroll
                    for (int bj = 0; bj < 2; ++bj) { const int h = (u.pn - 4) * 8 + bj * 4 + wc; const f32x4 x1 = acc[ai][bj][m][0], x2 = acc[ai][bj][m][1];
                        const f32x4 o1 = (x1 * cs - x2 * sn) * C2, o2 = (x2 * cs + x1 * sn) * C2;
                        bf16_t* p = row < MP ? QP + (size_t)row * 1536 + h * 96 + 64 + 4 * fq : QS + (size_t)(row - MP) * 4608 + h * 288 + 256 + 4 * fq;
                        u32x2 w1, w2; w1.x = pk2(o1[0], o1[1]); w1.y = pk2(o1[2], o1[3]); w2.x = pk2(o2[0], o2[1]); w2.y = pk2(o2[2], o2[3]);
                        *(u32x2*)p = w1; *(u32x2*)(p + 16) = w2; }
                } }
    }
};
struct EpiQlat { static constexpr bool PERM = true; bf16_t* QS;
    __device__ __forceinline__ void operator()(AccRef acc, const Unit& u, int wr, int wc, int fr, int fq) const {
        const int row0 = u.lm * 256 + wr * 64 + fr;
#pragma unroll
        for (int ai = 0; ai < 2; ++ai)
#pragma unroll
            for (int m = 0; m < 4; ++m)
#pragma unroll
                for (int bj = 0; bj < 2; ++bj) { const int col = u.pn * 256 + bj * 128 + wc * 32 + 8 * fq, h = col >> 8, r = col & 255;
                    *(u32x4*)(QS + (size_t)(row0 + ai * 128 + m * 16) * 4608 + h * 288 + r) = pack8(acc[ai][bj][m][0] * C2, acc[ai][bj][m][1] * C2); }
    }
};
struct EpiKV { static constexpr bool PERM = true; bf16_t* KP; bf16_t* VP;
    __device__ __forceinline__ void operator()(AccRef acc, const Unit& u, int wr, int wc, int fr, int fq) const {
        const int row0 = u.pm * 256 + wr * 64 + fr;
#pragma unroll
        for (int ai = 0; ai < 2; ++ai)
#pragma unroll
            for (int m = 0; m < 4; ++m) { const size_t row = (size_t)(row0 + ai * 128 + m * 16);
#pragma unroll
                for (int bj = 0; bj < 2; ++bj) { const int col = u.pn * 256 + bj * 128 + wc * 32 + 8 * fq; const u32x4 w = pack8(acc[ai][bj][m][0], acc[ai][bj][m][1]);
                    if (u.pn < 4) *(u32x4*)(KP + row * 1024 + col) = w;        else *(u32x4*)(VP + row * 1024 + (col - 1024)) = w; } }
    }
};
struct EpiPlain { static constexpr bool PERM = true; bf16_t* O; int ldc;
    __device__ __forceinline__ void operator()(AccRef acc, const Unit& u, int wr, int wc, int fr, int fq) const {
        const int row0 = u.pm * 256 + wr * 64 + fr;
#pragma unroll
        for (int ai = 0; ai < 2; ++ai)
#pragma unroll
            for (int m = 0; m < 4; ++m)
#pragma unroll
                for (int bj = 0; bj < 2; ++bj) { const int col = u.pn * 256 + bj * 128 + wc * 32 + 8 * fq;
                    *(u32x4*)(O + (size_t)(row0 + ai * 128 + m * 16) * ldc + col) = pack8(acc[ai][bj][m][0], acc[ai][bj][m][1]); }
    }
};
}

namespace att {
constexpr float THR = 8.f;
__device__ __forceinline__ int crow(int r, int hi) { return (r & 3) + 8 * (r >> 2) + 4 * hi; }
__device__ __forceinline__ unsigned cvtpk(float lo, float hi) { unsigned r; asm volatile("v_cvt_pk_bf16_f32 %0, %1, %2" : "=v"(r) : "v"(lo), "v"(hi)); return r; }
template <int NVB> __device__ __forceinline__ int v_st(int k, int c) { const int kk = k;        return ((kk >> 3) * NVB + (c >> 5)) * 512 + ((kk & 7) * 32 + (c & 31)) * 2; }
__device__ __forceinline__ int v_rd_base(int lane) { return ((lane & 3) << 3) | (((lane >> 2) & 3) << 6) | (((lane >> 4) & 1) << 5) | (((lane >> 5) & 1) << 8); }
template <int OFF> __device__ __forceinline__ s16x4 tr_read(int vb) { s16x4 r; asm volatile("ds_read_b64_tr_b16 %0, %1 offset:%2" : "=&v"(r) : "v"(vb), "i"(OFF) : "memory"); return r; }
struct VFrag { s16x4 l0, h0, l1, h1, l2, h2, l3, h3; };
template <int NVB, int D0> __device__ __forceinline__ void pv_load(VFrag& f, int vb) {
    constexpr int KS = 2 * NVB * 512, HF = NVB * 512;
    f.l0 = tr_read<D0 * 512 + 0 * KS>(vb); f.h0 = tr_read<D0 * 512 + 0 * KS + HF>(vb); f.l1 = tr_read<D0 * 512 + 1 * KS>(vb); f.h1 = tr_read<D0 * 512 + 1 * KS + HF>(vb);
    f.l2 = tr_read<D0 * 512 + 2 * KS>(vb); f.h2 = tr_read<D0 * 512 + 2 * KS + HF>(vb); f.l3 = tr_read<D0 * 512 + 3 * KS>(vb); f.h3 = tr_read<D0 * 512 + 3 * KS + HF>(vb);
}
template <int PENDING> __device__ __forceinline__ void pv_mma(f32x16& od, const VFrag& f, bf16x8 pa0, bf16x8 pa1, bf16x8 pa2, bf16x8 pa3) {
    if constexpr (PENDING == 8) asm volatile("s_waitcnt lgkmcnt(8)" ::: "memory"); else asm volatile("s_waitcnt lgkmcnt(0)" ::: "memory"); __builtin_amdgcn_sched_barrier(0);
#define PK(L, H) (bf16x8){L[0], L[1], L[2], L[3], H[0], H[1], H[2], H[3]}
    od = __builtin_amdgcn_mfma_f32_32x32x16_bf16(PK(f.l0, f.h0), pa0, od, 0, 0, 0);
    od = __builtin_amdgcn_mfma_f32_32x32x16_bf16(PK(f.l1, f.h1), pa1, od, 0, 0, 0);
    od = __builtin_amdgcn_mfma_f32_32x32x16_bf16(PK(f.l2, f.h2), pa2, od, 0, 0, 0);
    od = __builtin_amdgcn_mfma_f32_32x32x16_bf16(PK(f.l3, f.h3), pa3, od, 0, 0, 0);
#undef PK
}
template <int NVB, int D0> __device__ __forceinline__ void pv_one(f32x16& od, int vb, bf16x8 pa0, bf16x8 pa1, bf16x8 pa2, bf16x8 pa3) { VFrag f; pv_load<NVB, D0>(f, vb); pv_mma<0>(od, f, pa0, pa1, pa2, pa3); }
#define PK4(P, BASE, OUT) do { u32x4 w = {cvtpk(P[BASE + 0], P[BASE + 1]), cvtpk(P[BASE + 2], P[BASE + 3]), cvtpk(P[BASE + 4], P[BASE + 5]), cvtpk(P[BASE + 6], P[BASE + 7])}; OUT = __builtin_bit_cast(bf16x8, w); } while (0)
__device__ __forceinline__ bool softmax_tile(f32x16& p0, f32x16& p1, float& m_reg, float& l_reg, float& alpha, bf16x8& pa0, bf16x8& pa1, bf16x8& pa2, bf16x8& pa3) {
    float pmax = p0[0];
#pragma unroll
    for (int r = 1; r < 16; ++r) pmax = fmaxf(pmax, p0[r]);
#pragma unroll
    for (int r = 0; r < 16; ++r) pmax = fmaxf(pmax, p1[r]);
    { float lo_, hi_; half_swap(pmax, lo_, hi_); pmax = fmaxf(lo_, hi_); }
    float mn;
    if (__all(pmax - m_reg <= THR)) { mn = m_reg; alpha = 1.f; }
    else { mn = fmaxf(m_reg, pmax); alpha = ex2(m_reg - mn); m_reg = mn; }
    float ps = 0.f;
#pragma unroll
    for (int r = 0; r < 16; ++r) { p0[r] = ex2(p0[r] - mn); ps += p0[r]; }
#pragma unroll
    for (int r = 0; r < 16; ++r) { p1[r] = ex2(p1[r] - mn); ps += p1[r]; }
    { float lo_, hi_; half_swap(ps, lo_, hi_); ps = lo_ + hi_; }
    l_reg = l_reg * alpha + ps;
    PK4(p0, 0, pa0); PK4(p0, 8, pa1); PK4(p1, 0, pa2); PK4(p1, 8, pa3);
    return __any(alpha < 1.f);
}
__device__ __forceinline__ bool softmax_tile_rel(f32x16& p0, f32x16& p1, float& m_reg, float& l_reg, float& alpha, f32x16& negm, bool first, bf16x8& pa0, bf16x8& pa1, bf16x8& pa2, bf16x8& pa3) {
    f32x16 e0, e1; float ps = 0.f;
#pragma unroll
    for (int r = 0; r < 16; ++r) { e0[r] = ex2(p0[r]); ps += e0[r]; }
#pragma unroll
    for (int r = 0; r < 16; ++r) { e1[r] = ex2(p1[r]); ps += e1[r]; }
    const bool upd = first || !__all(ps <= 256.f);
    alpha = 1.f;
    if (upd) {
        float pmax = p0[0];
#pragma unroll
        for (int r = 1; r < 16; ++r) pmax = fmaxf(pmax, p0[r]);
#pragma unroll
        for (int r = 0; r < 16; ++r) pmax = fmaxf(pmax, p1[r]);
        float lo_, hi_; half_swap(pmax, lo_, hi_); pmax = fmaxf(lo_, hi_); const float d = first ? pmax : fmaxf(pmax, 0.f); alpha = first ? 1.f : ex2(-d); m_reg += d;
        ps = 0.f;
#pragma unroll
        for (int r = 0; r < 16; ++r) { e0[r] = ex2(p0[r] - d); ps += e0[r]; }
#pragma unroll
        for (int r = 0; r < 16; ++r) { e1[r] = ex2(p1[r] - d); ps += e1[r]; }
#pragma unroll
        for (int r = 0; r < 16; ++r) negm[r] = -m_reg; }
    l_reg = l_reg * alpha + ps;
    PK4(e0, 0, pa0); PK4(e0, 8, pa1); PK4(e1, 0, pa2); PK4(e1, 8, pa3);
    return upd && !first;
}
#undef PK4

template <bool SAMPLE>
__device__ __forceinline__ void attn_unit(char* lds, const bf16_t* __restrict__ Qrow  , const bf16_t* __restrict__ Kg, const bf16_t* __restrict__ Vg, int NT, int jmax,
                                          bf16_t* __restrict__ Orow0  , int ldo, int vcol0  ) {
    constexpr int NKS = SAMPLE ? 18 : 6, NCB = SAMPLE ? 4 : 2, NVB = SAMPLE ? 8 : 2, KROWB = SAMPLE ? 592 : 208, KBYTES = 64 * KROWB, VBYTES = 64 * NVB * 64, BUF = KBYTES + VBYTES;
    constexpr int LDK = SAMPLE ? 288 : 1536, LDV = SAMPLE ? 288 : 1024, KCH = SAMPLE ? 36 : 12, NKC = 64 * KCH, NSTG = SAMPLE ? 5 : 2;
    int tid_ = threadIdx.x; asm volatile("" : "+v"(tid_));
    const int tid = tid_, wid = tid >> 6, lane = tid & 63, r32 = lane & 31, hi = lane >> 5;
    float* wsf = (float*)(lds + 2 * BUF) + wid * 64; float* li_l = wsf; float* al_l = wsf + 32;
    bf16x8 qr[NKS];
#pragma unroll
    for (int d0 = 0; d0 < NKS; ++d0) qr[d0] = *(const bf16x8*)(Qrow + d0 * 16);
    int srow[NSTG], sch[NSTG];
#pragma unroll
    for (int k = 0; k < NSTG; ++k) { const int idx = tid + 512 * k; srow[k] = idx / KCH; sch[k] = idx % KCH; }
    bf16x8 sk[NSTG]; bf16x8 sv;
#define SLOAD(t) do { _Pragma("unroll") for (int k = 0; k < NSTG; ++k) if (tid + 512 * k < NKC) sk[k] = *(const bf16x8*)(Kg + (size_t)((t) * 64 + srow[k]) * LDK + sch[k] * 8); \
        if (!SAMPLE) sv = *(const bf16x8*)(Vg + (size_t)((t) * 64 + (tid >> 3)) * LDV + (tid & 7) * 8); } while (0)
#define SWRITE(b) do { char* kb_ = lds + (b) * BUF; _Pragma("unroll") for (int k = 0; k < NSTG; ++k) if (tid + 512 * k < NKC) { *(bf16x8*)(kb_ + srow[k] * KROWB + sch[k] * 16) = sk[k]; \
            if (SAMPLE && sch[k] < 32) *(bf16x8*)(kb_ + KBYTES + v_st<NVB>(srow[k], sch[k] * 8)) = sk[k]; } \
        if (!SAMPLE) *(bf16x8*)(kb_ + KBYTES + v_st<NVB>(tid >> 3, (tid & 7) * 8)) = sv; } while (0)
    float m_reg = SAMPLE ? -1e30f : 0.f, l_reg = 0.f; f32x16 o[NCB]; f32x16 negm = f32x16{};
#pragma unroll
    for (int d = 0; d < NCB; ++d) o[d] = f32x16{};
    const int vb0 = (int)(unsigned)(uintptr_t)lds + KBYTES + v_rd_base(lane) + vcol0 * 512;
    SLOAD(0); SWRITE(0); if (NT > 1) SLOAD(1);
    __syncthreads();
    for (int j = 0; j < NT; ++j) {
        const int b = j & 1;
        if (j <= jmax) {
            const char* Ks = lds + b * BUF;
            f32x16 p0 = f32x16{}, p1 = f32x16{};
#pragma unroll
            for (int d0 = 0; d0 < NKS; ++d0) { const int cb = (d0 * 16 + hi * 8) * 2;
                const bf16x8 k0 = *(const bf16x8*)(Ks + r32 * KROWB + cb), k1 = *(const bf16x8*)(Ks + (32 + r32) * KROWB + cb);
                if (!SAMPLE && d0 == 0) { p0 = __builtin_amdgcn_mfma_f32_32x32x16_bf16(k0, qr[0], negm, 0, 0, 0); p1 = __builtin_amdgcn_mfma_f32_32x32x16_bf16(k1, qr[0], negm, 0, 0, 0); }
                else { p0 = __builtin_amdgcn_mfma_f32_32x32x16_bf16(k0, qr[d0], p0, 0, 0, 0); p1 = __builtin_amdgcn_mfma_f32_32x32x16_bf16(k1, qr[d0], p1, 0, 0, 0); } }
            float alpha; bf16x8 pa0, pa1, pa2, pa3;
            bool resc;
            if constexpr (SAMPLE) resc = softmax_tile(p0, p1, m_reg, l_reg, alpha, pa0, pa1, pa2, pa3);
            else resc = softmax_tile_rel(p0, p1, m_reg, l_reg, alpha, negm, j == 0, pa0, pa1, pa2, pa3);
            if (resc) {
#pragma unroll
                for (int d = 0; d < NCB; ++d)
#pragma unroll
                    for (int r = 0; r < 16; ++r) o[d][r] *= alpha; }
            const int vb = vb0 + b * BUF;
            pv_one<NVB, 0>(o[0], vb, pa0, pa1, pa2, pa3); pv_one<NVB, 1>(o[1], vb, pa0, pa1, pa2, pa3);
            if constexpr (NCB == 4) { pv_one<NVB, 2>(o[2], vb, pa0, pa1, pa2, pa3); pv_one<NVB, 3>(o[3], vb, pa0, pa1, pa2, pa3); }
        }
        if (j + 1 < NT) SWRITE(b ^ 1);
        if (j + 2 < NT) SLOAD(j + 2);
        __syncthreads();
    }
    if constexpr (!SAMPLE) { float lo_, hi_; half_swap(l_reg, lo_, hi_); l_reg = lo_ + hi_; }
    { const float rl = __builtin_amdgcn_rcpf(l_reg); bf16_t* orow = Orow0 + (size_t)r32 * ldo + 4 * hi;
#pragma unroll
      for (int d0 = 0; d0 < NCB; ++d0)
#pragma unroll
          for (int i = 0; i < 4; ++i) { u32x2 w; w.x = pk2(o[d0][4 * i] * rl, o[d0][4 * i + 1] * rl); w.y = pk2(o[d0][4 * i + 2] * rl, o[d0][4 * i + 3] * rl); *(u32x2*)(orow + d0 * 32 + 8 * i) = w; } }
    __syncthreads();
#undef SLOAD
#undef SWRITE
}

__device__ __forceinline__ void attn_unit_p2(char* lds, const bf16_t* __restrict__ Qrow, const bf16_t* __restrict__ Kg, const bf16_t* __restrict__ Kpe  , const bf16_t* __restrict__ Vg, int NT, int jmax, bf16_t* __restrict__ Orow0, int ldo) {
    constexpr int NKS = 6, NVB = 2, KROWB = 208, KBYTES = 64 * KROWB, VBYTES = 64 * NVB * 64, TB = KBYTES + VBYTES, BUF = 3 * TB, LDK = 1024, LDV = 1024, KCH = 12, NKC = 64 * KCH;
    int tid_ = threadIdx.x; asm volatile("" : "+v"(tid_));
    const int tid = tid_, lane = tid & 63, r32 = lane & 31, hi = lane >> 5;
    bf16x8 qr[NKS];
#pragma unroll
    for (int d0 = 0; d0 < NKS; ++d0) qr[d0] = *(const bf16x8*)(Qrow + d0 * 16);
    const int sr0 = tid / KCH, sc0 = tid % KCH, sr1 = (tid + 512) / KCH, sc1 = (tid + 512) % KCH; const bool two = tid + 512 < NKC;
    const bf16_t* kp0 = sc0 < 8 ? Kg + (size_t)sr0 * LDK + sc0 * 8 : Kpe + (size_t)sr0 * 32 + (sc0 - 8) * 8; const int ks0 = sc0 < 8 ? 64 * LDK : 64 * 32;
    const bf16_t* kp1 = sc1 < 8 ? Kg + (size_t)sr1 * LDK + sc1 * 8 : Kpe + (size_t)sr1 * 32 + (sc1 - 8) * 8; const int ks1 = sc1 < 8 ? 64 * LDK : 64 * 32;
    bf16x8 ka0, ka1 = bf16x8{}, va, kb0, kb1 = bf16x8{}, vb_, kc0, kc1 = bf16x8{}, vc;
#define SLOAD1(t, K0, K1, V_) do { const int t_ = (t) < NT ? (t) : NT - 1; K0 = *(const bf16x8*)(kp0 + (size_t)t_ * ks0); if (two) K1 = *(const bf16x8*)(kp1 + (size_t)t_ * ks1); \
        V_ = *(const bf16x8*)(Vg + (size_t)(t_ * 64 + (tid >> 3)) * LDV + (tid & 7) * 8); } while (0)
#define SWRITE1(base_, K0, K1, V_) do { char* kb_ = (base_); *(bf16x8*)(kb_ + sr0 * KROWB + sc0 * 16) = K0; if (two) *(bf16x8*)(kb_ + sr1 * KROWB + sc1 * 16) = K1; \
        *(bf16x8*)(kb_ + KBYTES + v_st<NVB>(tid >> 3, (tid & 7) * 8)) = V_; } while (0)
#define SLOAD3(pr) do { SLOAD1(3 * (pr), ka0, ka1, va); SLOAD1(3 * (pr) + 1, kb0, kb1, vb_); SLOAD1(3 * (pr) + 2, kc0, kc1, vc); } while (0)
#define SWRITE3(st_) do { SWRITE1(lds + (st_) * BUF, ka0, ka1, va); SWRITE1(lds + (st_) * BUF + TB, kb0, kb1, vb_); SWRITE1(lds + (st_) * BUF + 2 * TB, kc0, kc1, vc); } while (0)
    float m_reg = 0.f, l_reg = 0.f; f32x16 o0 = f32x16{}, o1 = f32x16{}, negm = f32x16{};
    const int vrd = (int)(unsigned)(uintptr_t)lds + KBYTES + v_rd_base(lane);
#define KPRE(off_, A_, B_) do { const char* Ks_ = lds + (off_) + hi * 16; A_ = *(const bf16x8*)(Ks_ + r32 * KROWB); B_ = *(const bf16x8*)(Ks_ + (32 + r32) * KROWB); } while (0)
#define TILE_QS(off_, first_, A_, B_) do { const char* Ks = lds + (off_); f32x16 p0, p1; \
        p0 = __builtin_amdgcn_mfma_f32_32x32x16_bf16(A_, qr[0], negm, 0, 0, 0); p1 = __builtin_amdgcn_mfma_f32_32x32x16_bf16(B_, qr[0], negm, 0, 0, 0); \
        _Pragma("unroll") for (int d0 = 1; d0 < NKS; ++d0) { const int cb = (d0 * 16 + hi * 8) * 2; \
            const bf16x8 k0 = *(const bf16x8*)(Ks + r32 * KROWB + cb), k1 = *(const bf16x8*)(Ks + (32 + r32) * KROWB + cb); \
            p0 = __builtin_amdgcn_mfma_f32_32x32x16_bf16(k0, qr[d0], p0, 0, 0, 0); p1 = __builtin_amdgcn_mfma_f32_32x32x16_bf16(k1, qr[d0], p1, 0, 0, 0); } \
        pv_load<NVB, 0>(vf0, vrd + (off_)); \
        float alpha; const bool resc = softmax_tile_rel(p0, p1, m_reg, l_reg, alpha, negm, (first_), pa0, pa1, pa2, pa3); \
        if (resc) { _Pragma("unroll") for (int r = 0; r < 16; ++r) { o0[r] *= alpha; o1[r] *= alpha; } } } while (0)
#define TILE_PV(off_) do { VFrag vf1; pv_load<NVB, 1>(vf1, vrd + (off_)); pv_mma<8>(o0, vf0, pa0, pa1, pa2, pa3); pv_mma<0>(o1, vf1, pa0, pa1, pa2, pa3); } while (0)
    const int NP = (NT + 2) / 3;
    SLOAD3(0); SWRITE3(0); if (NP > 1) SLOAD3(1);
    __syncthreads();
    for (int jj = 0; jj < NP; ++jj) {
        const int so = (jj & 1) * BUF;
        if (3 * jj <= jmax) { bf16x8 fa, fb, pa0, pa1, pa2, pa3; VFrag vf0;
            KPRE(so, fa, fb); TILE_QS(so, jj == 0, fa, fb);
            if (3 * jj + 1 <= jmax) KPRE(so + TB, fa, fb);
            TILE_PV(so);
            if (3 * jj + 1 <= jmax) { TILE_QS(so + TB, false, fa, fb);
                if (3 * jj + 2 <= jmax) KPRE(so + 2 * TB, fa, fb);
                TILE_PV(so + TB);
                if (3 * jj + 2 <= jmax) { TILE_QS(so + 2 * TB, false, fa, fb); TILE_PV(so + 2 * TB); } } }
        if (jj + 1 < NP) SWRITE3((jj & 1) ^ 1);
        if (jj + 2 < NP) SLOAD3(jj + 2);
        __syncthreads();
    }
#undef SLOAD1
#undef SWRITE1
#undef SLOAD3
#undef SWRITE3
#undef KPRE
#undef TILE_QS
#undef TILE_PV
    { float lo_, hi_; half_swap(l_reg, lo_, hi_); l_reg = lo_ + hi_; }
    { const float rl = __builtin_amdgcn_rcpf(l_reg); bf16_t* orow = Orow0 + (size_t)r32 * ldo + 4 * hi;
#pragma unroll
      for (int i = 0; i < 4; ++i) { u32x2 w0, w1; w0.x = pk2(o0[4 * i] * rl, o0[4 * i + 1] * rl); w0.y = pk2(o0[4 * i + 2] * rl, o0[4 * i + 3] * rl); w1.x = pk2(o1[4 * i] * rl, o1[4 * i + 1] * rl); w1.y = pk2(o1[4 * i + 2] * rl, o1[4 * i + 3] * rl);
          *(u32x2*)(orow + 8 * i) = w0; *(u32x2*)(orow + 32 + 8 * i) = w1; } }
    __syncthreads();
}
}

#define XB_TMO      128
#define XB_XCNT(j)  (256  + 64 * (j))
#define XB_XSUB(j)  (1280 + 64 * (j))
#define XB_XGEN(j)  (2304 + 64 * (j))
#define XB_TOP      3328
#define XB_TOPGEN   3392
#define XCD_BAR_WORDS 3456
#define XB_SPIN_CAP (1u << 22)
__device__ __forceinline__ unsigned xb_ld(unsigned* p)              { return __hip_atomic_load(p, __ATOMIC_RELAXED, __HIP_MEMORY_SCOPE_AGENT); }
__device__ __forceinline__ unsigned xb_add(unsigned* p, unsigned v) { return __hip_atomic_fetch_add(p, v, __ATOMIC_RELAXED, __HIP_MEMORY_SCOPE_AGENT); }
__device__ __forceinline__ unsigned xb_xcc_id() { return (unsigned)__builtin_amdgcn_s_getreg((3 << 11) | 20) & 0xFu; }
#define XB_SPIN(cond, bar) do { unsigned _sp = 0; while (cond) { __builtin_amdgcn_s_sleep(1); \
    if ((++_sp & 255u) == 0u) { if (xb_ld(&(bar)[XB_TMO])) break; if (_sp > XB_SPIN_CAP) { atomicAdd(&(bar)[XB_TMO], 1u); break; } } } } while (0)
struct XcdBarrier { unsigned* bar; unsigned x; volatile LAS unsigned* st; };
__device__ __forceinline__ XcdBarrier xcd_barrier_post(unsigned* bar, volatile LAS unsigned* st) {
    XcdBarrier b; b.bar = bar; b.x = xb_xcc_id(); b.st = st;
    if (threadIdx.x == 0) (void)xb_add(&bar[XB_XCNT(b.x)], 1u);
    return b;
}
__device__ __forceinline__ void xcd_barrier_complete(unsigned* bar, unsigned x, unsigned& nloc, unsigned& nx) {
    const unsigned G = gridDim.x * gridDim.y * gridDim.z;
    unsigned sum, cnt, mine, sp = 0u;
    for (;;) {
        sum = 0u; cnt = 0u; mine = 0u;
#pragma unroll
        for (unsigned j = 0; j < 16; ++j) { const unsigned c = xb_ld(&bar[XB_XCNT(j)]); sum += c; cnt += (c > 0u) ? 1u : 0u; mine = (j == x) ? c : mine; }
        if (sum == G) break;
        __builtin_amdgcn_s_sleep(1);
        if ((++sp & 255u) == 0u) { if (xb_ld(&bar[XB_TMO])) break; if (sp > XB_SPIN_CAP) { atomicAdd(&bar[XB_TMO], 1u); break; } }
    }
    nloc = mine > 0u ? mine : 1u; nx = cnt > 0u ? cnt : 1u;
}
__device__ __forceinline__ void xcd_barrier(const XcdBarrier& b) {
    asm volatile("s_waitcnt vmcnt(0)" ::: "memory");
    __syncthreads();
    if (threadIdx.x == 0) {
        unsigned* bar = b.bar;
        __builtin_amdgcn_s_waitcnt(0);
        unsigned nloc = b.st[0], nx = b.st[1];
        if (nloc == 0u) { xcd_barrier_complete(bar, b.x, nloc, nx); b.st[0] = nloc; b.st[1] = nx; }
        const unsigned old = xb_add(&bar[XB_XSUB(b.x)], 1u);
        const unsigned gen = old / nloc;
        if (old + 1u == (gen + 1u) * nloc) {
            __builtin_amdgcn_fence(__ATOMIC_RELEASE, "agent");
            asm volatile("s_waitcnt vmcnt(0)" ::: "memory");
            const unsigned og = xb_add(&bar[XB_TOP], 1u);
            const unsigned tg = og / nx;
            if (og + 1u == (tg + 1u) * nx) xb_add(&bar[XB_TOPGEN], 1u);
            else XB_SPIN(xb_ld(&bar[XB_TOPGEN]) == tg, bar);
            __builtin_amdgcn_fence(__ATOMIC_ACQUIRE, "agent");
            xb_add(&bar[XB_XGEN(b.x)], 1u);
            asm volatile("s_waitcnt vmcnt(0)" ::: "memory");
        } else {
            XB_SPIN(xb_ld(&bar[XB_XGEN(b.x)]) == gen, bar);
            __builtin_amdgcn_fence(__ATOMIC_ACQUIRE, "agent");
            asm volatile("s_waitcnt vmcnt(0)" ::: "memory");
        }
    }
    __syncthreads();
}


__device__ __forceinline__ void ln_load(const bf16_t* T, const bf16_t* XBo, const float* PARTp, float pscale, int row, int lane, float (&v)[32]) {
    if (row >= MP) {
#pragma unroll
        for (int j = 0; j < 4; ++j) { const int c = 512 * j + 8 * lane; const u32x4 xw = *(const u32x4*)(XBo + (size_t)row * DM + c); const float* pp = PARTp + (size_t)(row - MP) * DM + c;
            const float xs[8] = {bflo(xw.x), bfhi(xw.x), bflo(xw.y), bfhi(xw.y), bflo(xw.z), bfhi(xw.z), bflo(xw.w), bfhi(xw.w)};
#pragma unroll
            for (int h = 0; h < 2; ++h) { const f32x4 ps = *(const f32x4*)(pp + 4 * h) + *(const f32x4*)(pp + 4 * h + (size_t)MS * DM) + *(const f32x4*)(pp + 4 * h + (size_t)2 * MS * DM) + *(const f32x4*)(pp + 4 * h + (size_t)3 * MS * DM);
#pragma unroll
                for (int e = 0; e < 4; ++e) v[8 * j + 4 * h + e] = xs[4 * h + e] * ALPHA + ps[e] * pscale; } }
    } else {
#pragma unroll
        for (int j = 0; j < 4; ++j) { const u32x4 tw = *(const u32x4*)(T + (size_t)row * DM + 512 * j + 8 * lane);
            v[8 * j + 0] = bflo(tw.x); v[8 * j + 1] = bfhi(tw.x); v[8 * j + 2] = bflo(tw.y); v[8 * j + 3] = bfhi(tw.y); v[8 * j + 4] = bflo(tw.z); v[8 * j + 5] = bfhi(tw.z); v[8 * j + 6] = bflo(tw.w); v[8 * j + 7] = bfhi(tw.w); }
    }
}
__device__ __forceinline__ void ln_store(bf16_t* XBo, float* Y, const float (&g)[32], const float (&bb)[32], int row, int lane, float (&v)[32], float mu, float r) {
#pragma unroll
    for (int j = 0; j < 4; ++j) { const int c = 512 * j + 8 * lane;
        const f32x4 o0 = ((f32x4){v[8 * j], v[8 * j + 1], v[8 * j + 2], v[8 * j + 3]} - mu) * r * (f32x4){g[8 * j], g[8 * j + 1], g[8 * j + 2], g[8 * j + 3]} + (f32x4){bb[8 * j], bb[8 * j + 1], bb[8 * j + 2], bb[8 * j + 3]};
        const f32x4 o1 = ((f32x4){v[8 * j + 4], v[8 * j + 5], v[8 * j + 6], v[8 * j + 7]} - mu) * r * (f32x4){g[8 * j + 4], g[8 * j + 5], g[8 * j + 6], g[8 * j + 7]} + (f32x4){bb[8 * j + 4], bb[8 * j + 5], bb[8 * j + 6], bb[8 * j + 7]};
        if (Y) { *(f32x4*)(Y + (size_t)row * DM + c) = o0; *(f32x4*)(Y + (size_t)row * DM + c + 4) = o1; }
        else *(u32x4*)(XBo + (size_t)row * DM + c) = pack8(o0, o1); }
}
__device__ __forceinline__ void ln_pass(const bf16_t* T, bf16_t* XBo, float* Y, const float* PARTp, float pscale, const float* lg, const float* lb, int gw, int NGW, int lane) {
    float g[32], bb[32];
#pragma unroll
    for (int j = 0; j < 4; ++j) { const int c = 512 * j + 8 * lane; const f32x4 g0 = *(const f32x4*)(lg + c), g1 = *(const f32x4*)(lg + c + 4), b0 = *(const f32x4*)(lb + c), b1 = *(const f32x4*)(lb + c + 4);
#pragma unroll
        for (int e = 0; e < 4; ++e) { g[8 * j + e] = g0[e]; g[8 * j + 4 + e] = g1[e]; bb[8 * j + e] = b0[e]; bb[8 * j + 4 + e] = b1[e]; } }
    const int nk = (MT - gw + NGW - 1) / NGW;
    for (int q = 0; q < nk; q += 2) {
        const int kA = q == 0 ? nk - 1 : q - 1, kB = q; const bool hasB = q + 1 < nk; const int row = gw + kA * NGW, rowB = gw + kB * NGW; const int rB = hasB ? rowB : row;
        float va[32], vb[32];
        ln_load(T, XBo, PARTp, pscale, row, lane, va); ln_load(T, XBo, PARTp, pscale, rB, lane, vb);
        float sa = 0.f, sb = 0.f;
#pragma unroll
        for (int e = 0; e < 32; ++e) { sa += va[e]; sb += vb[e]; }
        const float mua = wave_sum(sa) * (1.f / DM), mub = wave_sum(sb) * (1.f / DM); float qa = 0.f, qb = 0.f;
#pragma unroll
        for (int e = 0; e < 32; ++e) { const float da = va[e] - mua, db = vb[e] - mub; qa += da * da; qb += db * db; }
        const float ra = 1.f / sqrtf(wave_sum(qa) * (1.f / DM) + LN_EPS), rb_ = 1.f / sqrtf(wave_sum(qb) * (1.f / DM) + LN_EPS);
        ln_store(XBo, Y, g, bb, row, lane, va, mua, ra);
        if (hasB) ln_store(XBo, Y, g, bb, rowB, lane, vb, mub, rb_);
    }
}

__device__ __forceinline__ void transpose_item(const GAS float* W, int K, int N, GAS bf16_t* WT, int ldt, int coff, int map, int p0, int item, int lane) {
    const int nblk = (N + 63) >> 6, kc = item / nblk, nb = item - kc * nblk, n = nb * 64 + lane, k0 = kc * 256, k1 = (k0 + 256 < K) ? k0 + 256 : K;
    if (n < N) {
        int drow;
        if (map == 0) drow = n + p0;
        else if (map == 1) drow = (n >> 7) * 256 + (n & 127) + p0;
        else if (map == 2) drow = n < 768 ? n : (n < 800 ? 2816 + (n - 768) : n - 32);
        else { const int h = n / 96, e = n - h * 96; if (e < 64) drow = h * 64 + e; else { const int i2 = e - 64; drow = 1024 + h * 32 + 8 * ((i2 & 15) >> 2) + 4 * (i2 >> 4) + (i2 & 3); } }
        const GAS float* src = W + (size_t)k0 * N + n; GAS bf16_t* dst = WT + (size_t)drow * ldt + coff + k0;
#pragma unroll 4
        for (int k = k0; k < k1; k += 8) { float v[8];
#pragma unroll
            for (int j = 0; j < 8; ++j) v[j] = src[(size_t)j * N];
            u32x4 o; o.x = pk2(v[0], v[1]); o.y = pk2(v[2], v[3]); o.z = pk2(v[4], v[5]); o.w = pk2(v[6], v[7]);
            *(GAS u32x4*)dst = o; src += (size_t)8 * N; dst += 8; }
    }
}
struct Args { const float* in[40]; float* out; unsigned char* ws; };

struct SsmLam { double lr, li, dt; };
__device__ __forceinline__ SsmLam ssm_lam(const float* lam_re, const float* lam_im, const float* log_dt, int g, int p) { SsmLam s; s.lr = lam_re[g * 64 + p]; s.li = lam_im[g * 64 + p]; s.dt = dexp((double)log_dt[g]); return s; }
__device__ __forceinline__ void ssm_pow(const SsmLam& s, int k, double& wr, double& wi) { const double mag = dexp(s.lr * s.dt * k); double sn, cs; dsincos(s.li * s.dt * k, sn, cs); wr = mag * cs; wi = mag * sn; }
__device__ __forceinline__ void ssm_co(const SsmLam& s, double& cr, double& ci) { double ar, ai; ssm_pow(s, 1, ar, ai); const double den = s.lr * s.lr + s.li * s.li, nr = ar - 1.0; cr = (nr * s.lr + ai * s.li) / den; ci = (ai * s.lr - nr * s.li) / den; }

#define WUP ((bf16_t*)(ws + WS_WUP))
#define WDN ((bf16_t*)(ws + WS_WDN))
#define WINE ((bf16_t*)(ws + WS_WINE))
#define WOUTE ((bf16_t*)(ws + WS_WOUTE))
#define WINO ((bf16_t*)(ws + WS_WINO))
#define WOUTO ((bf16_t*)(ws + WS_WOUTO))
#define WMIXS ((bf16_t*)(ws + WS_WMIXS))
#define AEXPK ((bf16_t*)(ws + WS_AEXPK))
#define AEXPV ((bf16_t*)(ws + WS_AEXPV))
#define WQLAT ((bf16_t*)(ws + WS_WQLAT))
#define WPOOL ((bf16_t*)(ws + WS_WPOOL))
#define WUQ ((bf16_t*)(ws + WS_WUQ))
#define WKV ((bf16_t*)(ws + WS_WKV))
#define WUQN ((bf16_t*)(ws + WS_WUQN))
#define WGLU ((bf16_t*)(ws + WS_WGLU))
#define WSG ((bf16_t*)(ws + WS_WSG))
#define BT1 ((bf16_t*)(ws + WS_BT1))
#define BT2 ((bf16_t*)(ws + WS_BT2))
#define ROPE ((float*)(ws + WS_ROPE))
#define KTAB ((float*)(ws + WS_KTAB))
#define A64 ((float*)(ws + WS_A64))
#define XB ((bf16_t*)(ws + WS_XB))
#define HB ((bf16_t*)(ws + WS_H))
#define ZP ((bf16_t*)(ws + WS_ZP))
#define DP ((bf16_t*)(ws + WS_DP))
#define UP ((bf16_t*)(ws + WS_UP))
#define S1 ((float*)(ws + WS_S1))
#define GACT ((bf16_t*)(ws + WS_GACT))
#define HISTB ((bf16_t*)(ws + WS_HISTB))
#define ZQ ((float*)(ws + WS_ZQ))
#define ZC ((float*)(ws + WS_ZC))
#define ZK ((float*)(ws + WS_ZK))
#define UB ((bf16_t*)(ws + WS_UB))
#define VPRE ((bf16_t*)(ws + WS_VPRE))
#define VB ((bf16_t*)(ws + WS_VB))
#define CQN ((bf16_t*)(ws + WS_CQN))
#define CKVB ((bf16_t*)(ws + WS_CKVB))
#define KPEB ((bf16_t*)(ws + WS_KPEB))
#define AS ((bf16_t*)(ws + WS_AS))
#define PART ((float*)(ws + WS_PART))
#define KP ((bf16_t*)(ws + WS_KP))
#define QP ((bf16_t*)(ws + WS_QP))
#define QS ((bf16_t*)(ws + WS_QS))
#define VP ((bf16_t*)(ws + WS_VP))
#define KXS ((bf16_t*)(ws + WS_KXS))
#define TB ((bf16_t*)out)
#define MIX ((bf16_t*)((unsigned char*)out + 136 * MiB))
#define TFIN ((bf16_t*)(ws + 8 * MiB))
typedef const __attribute__((address_space(4))) Args* ArgsP;
#define PHASE_BEGIN() ArgsP ap = kap; asm volatile("" : "+s"(ap)); unsigned char* const ws = ap->ws; float* const out = ap->out; (void)ws; (void)out; \
    int tid = threadIdx.x; asm volatile("" : "+v"(tid)); int bx = blockIdx.x; asm volatile("" : "+s"(bx)); int G = gridDim.x; asm volatile("" : "+s"(G)); \
    const int lane = tid & 63, wave = __builtin_amdgcn_readfirstlane(tid >> 6), vcu = (G % 8 == 0) ? (bx % 8) * (G / 8) + bx / 8 : bx, gw = bx * NW + wave, NGW = G * NW; \
    const long gt = (long)bx * (NW * 64) + tid, NGT = (long)G * NW * 64; (void)lane; (void)wave; (void)vcu; (void)gw; (void)NGW; (void)gt; (void)NGT
__global__ void __launch_bounds__(NW * 64, 2) fwd_kernel(Args a_unused) {
    extern __shared__ __attribute__((aligned(16))) unsigned char lds_raw[];
    LAS unsigned char* lds = (LAS unsigned char*)lds_raw;
    volatile LAS unsigned* MISC = (volatile LAS unsigned*)(lds + LDSCTL_OFF);
    const ArgsP kap = (ArgsP)__builtin_amdgcn_kernarg_segment_ptr();
    unsigned* ctl = (unsigned*)(kap->ws + WS_CTL);
    if (threadIdx.x < 64) MISC[threadIdx.x] = 0u;
    __syncthreads();
    XcdBarrier bar = xcd_barrier_post(ctl + CW_BAR, MISC + 8);
#define GRID_BAR() do { XcdBarrier b_ = bar; asm volatile("" : "+s"(b_.bar), "+s"(b_.x)); xcd_barrier(b_); } while (0)

    { PHASE_BEGIN();
    {
        LAS unsigned long long* jsrc = (LAS unsigned long long*)(lds + 72 * 1024); LAS unsigned long long* jdst = jsrc + 32;
        LAS int* jK = (LAS int*)(jdst + 32); LAS int* jN = jK + 32; LAS int* jld = jN + 32; LAS int* jco = jld + 32; LAS int* jmap = jco + 32; LAS int* jp0 = jmap + 32; LAS int* jst = jp0 + 32;
        if (tid == 0) {
            int nj = 0, st = 0;
#define ADDJOB(src_, K_, N_, dst_, ld_, co_, map_, p0_) do { jsrc[nj] = (unsigned long long)(uintptr_t)(src_); jdst[nj] = (unsigned long long)(uintptr_t)(dst_); jK[nj] = (K_); jN[nj] = (N_); jld[nj] = (ld_); jco[nj] = (co_); \
                jmap[nj] = (map_); jp0[nj] = (p0_); jst[nj] = st; st += (((K_) + 255) / 256) * (((N_) + 63) / 64); ++nj; } while (0)
            for (int l = 0; l < 1; ++l) for (int f = 0; f < 1; ++f) { const int idx = l * 2 + f;
                ADDJOB(ap->in[9 + 3 * f] + (size_t)l * DM * FF, DM, FF, WUP + (size_t)idx * 11264 * DM, DM, 0, 1, 0);
                ADDJOB(ap->in[10 + 3 * f] + (size_t)l * DM * FF, DM, FF, WUP + (size_t)idx * 11264 * DM, DM, 0, 1, 128);
                ADDJOB(ap->in[11 + 3 * f] + (size_t)l * FF * DM, FF, DM, WDN + (size_t)idx * DM * FF, FF, 0, 0, 0); }
            ADDJOB(ap->in[15], DM, DM, WINE, DM, 0, 0, 0);
            for (int g = 0; g < 4; ++g) ADDJOB(ap->in[16] + (size_t)g * 384 * 384, 384, 384, WPOOL + (size_t)g * 512 * 384, 384, 0, 0, 0);
            ADDJOB(ap->in[26], 512, 512, WGLU, 512, 0, 0, 0);
            ADDJOB(ap->in[28], DM, DM, WOUTE, DM, 0, 0, 0);
            ADDJOB(ap->in[29], DM, 2848, WINO, DM, 0, 2, 0);
            ADDJOB(ap->in[32], 512, 1536, WUQ, 512, 0, 3, 0);
            ADDJOB(ap->in[33], 256, 1024, WKV, 256, 0, 0, 0);
            ADDJOB(ap->in[34], 256, 1024, WKV, 256, 0, 0, 1024);
            ADDJOB(ap->in[39], DM, DM, WOUTO, DM, 0, 0, 0);
            ADDJOB(ap->in[39] + (size_t)1024 * DM, 1024, DM, WMIXS, 5120, 4096, 0, 0);
            jst[nj] = st; jK[31] = nj;
#undef ADDJOB
        }
        __syncthreads();
        const int njobs = jK[31], total = jst[njobs];
        int jc = 0;
        for (int it = gw; it < total; it += NGW) {
            while (it >= jst[jc + 1]) ++jc;
            const GAS float* W = (const GAS float*)(uintptr_t)jsrc[jc]; GAS bf16_t* WT = (GAS bf16_t*)(uintptr_t)jdst[jc];
            const int K = jK[jc], N = jN[jc], ldt = jld[jc], coff = jco[jc], map = jmap[jc], p0 = jp0[jc], item = it - jst[jc];
            transpose_item(W, K, N, WT, ldt, coff, map, p0, item, lane);
        }
        for (long i = gt; i < (long)MT * DM / 8; i += NGT) { const long e = i * 8; const float* src = e < (long)MP * DM ? ap->in[0] + e : ap->in[1] + (e - (long)MP * DM);
            const f32x4 v0 = *(const f32x4*)src, v1 = *(const f32x4*)(src + 4); *(u32x4*)(XB + e) = pack8(v0, v1); }
        for (long i = gt; i < 512 * 1024 / 8; i += NGT) { const int s = (int)(i / 128), c = (int)(i % 128) * 8, h = c >> 6, d = c & 63; const float* src = ap->in[32] + (size_t)s * 1536 + h * 96 + d;
            *(u32x4*)(WUQN + (size_t)s * 1024 + c) = pack8(*(const f32x4*)src, *(const f32x4*)(src + 4)); }
        for (long i = gt; i < 2L * 4096 * 1024 / 8; i += NGT) { const int which = (int)(i / (4096 * 128)); const long r = i % (4096 * 128); const int mrow = (int)(r / 128), c = (int)(r % 128) * 8, h = mrow >> 8, rr = mrow & 255;
            u32x4 w = (u32x4){0u, 0u, 0u, 0u};
            if ((c >> 6) == h) { const float* src = ap->in[which ? 34 : 33] + (size_t)rr * 1024 + c; w = pack8(*(const f32x4*)src, *(const f32x4*)(src + 4)); }
            *(u32x4*)((which ? AEXPV : AEXPK) + (size_t)mrow * 1024 + c) = w; }
        for (long i = gt; i < 8 * 128 * 128; i += NGT) { const int s = (int)(i & 127), t = (int)((i >> 7) & 127); WSG[i] = (bf16_t)(s <= t ? f2bf(ap->in[37][i]) : 0u); }
        for (long i = gt; i < 16384 * 16; i += NGT) { const int pos = (int)(i >> 4), f = (int)(i & 15); const float inv = (float)dexp(-(double)f * (9.210340371976184 / 16.0)); const float ang = (float)pos * inv;
            double sn, cs; dsincos((double)ang, sn, cs); ROPE[(size_t)pos * 32 + f] = (float)cs; ROPE[(size_t)pos * 32 + 16 + f] = (float)sn; }
        for (long i = gt; i < 32 * 64 * 64; i += NGT) { const int ii = (int)(i & 63), p = (int)((i >> 6) & 63), g = (int)(i >> 12);
            const SsmLam L = ssm_lam(ap->in[18], ap->in[19], ap->in[20], g, p); double cr, ci, wr_, wi_; ssm_co(L, cr, ci); ssm_pow(L, 63 - ii, wr_, wi_);
            const double fr_ = wr_ * cr - wi_ * ci, fi_ = wr_ * ci + wi_ * cr;
            float re[16], im[16];
#pragma unroll
            for (int c = 0; c < 16; ++c) { const double br = ap->in[21][(size_t)(g * 64 + p) * 16 + c], bi = ap->in[22][(size_t)(g * 64 + p) * 16 + c]; re[c] = (float)(fr_ * br - fi_ * bi); im[c] = (float)(fr_ * bi + fi_ * br); }
            bf16_t* d0 = BT1 + ((size_t)g * 256 + p) * 1024 + (63 - ii) * 16; bf16_t* d1 = BT1 + ((size_t)g * 256 + 64 + p) * 1024 + (63 - ii) * 16;
            *(u32x4*)d0 = pack8((f32x4){re[0], re[1], re[2], re[3]}, (f32x4){re[4], re[5], re[6], re[7]}); *(u32x4*)(d0 + 8) = pack8((f32x4){re[8], re[9], re[10], re[11]}, (f32x4){re[12], re[13], re[14], re[15]});
            *(u32x4*)d1 = pack8((f32x4){im[0], im[1], im[2], im[3]}, (f32x4){im[4], im[5], im[6], im[7]}); *(u32x4*)(d1 + 8) = pack8((f32x4){im[8], im[9], im[10], im[11]}, (f32x4){im[12], im[13], im[14], im[15]}); }
        for (long i = gt; i < 32 * 64 * 64; i += NGT) { const int p = (int)(i & 63), j = (int)((i >> 6) & 63), g = (int)(i >> 12);
            const SsmLam L = ssm_lam(ap->in[18], ap->in[19], ap->in[20], g, p); double wr_, wi_; ssm_pow(L, j + 1, wr_, wi_);
#pragma unroll
            for (int c = 0; c < 16; ++c) { const double cr = ap->in[23][(size_t)(g * 16 + c) * 64 + p], ci = ap->in[24][(size_t)(g * 16 + c) * 64 + p];
                bf16_t* d = BT2 + ((size_t)g * 1024 + j * 16 + c) * 1152 + 1024 + p; d[0] = (bf16_t)f2bf((float)(cr * wr_ - ci * wi_)); d[64] = (bf16_t)f2bf((float)(-(cr * wi_ + ci * wr_))); } }
        for (long i = gt; i < 32 * 64; i += NGT) { const SsmLam L = ssm_lam(ap->in[18], ap->in[19], ap->in[20], (int)(i >> 6), (int)(i & 63)); double wr_, wi_; ssm_pow(L, 64, wr_, wi_); A64[i * 2] = (float)wr_; A64[i * 2 + 1] = (float)wi_; }
        for (int item = bx; item < 256; item += G) {
            const int g = item >> 3, kq = item & 7;
            LAS float* sB = (LAS float*)(lds + 80 * 1024);
            LAS float* sC = sB + 2048;
            LAS float* sW = sC + 2048;
            for (int e = tid; e < 1024; e += NW * 64) { const int p = e >> 4, c = e & 15; const SsmLam L = ssm_lam(ap->in[18], ap->in[19], ap->in[20], g, p); double cr, ci; ssm_co(L, cr, ci);
                const double br = ap->in[21][(size_t)(g * 64 + p) * 16 + c], bi = ap->in[22][(size_t)(g * 64 + p) * 16 + c]; sB[e * 2] = (float)(cr * br - ci * bi); sB[e * 2 + 1] = (float)(cr * bi + ci * br);
                const int c2 = e >> 6, p2 = e & 63; sC[e * 2] = ap->in[23][(size_t)(g * 16 + c2) * 64 + p2]; sC[e * 2 + 1] = ap->in[24][(size_t)(g * 16 + c2) * 64 + p2]; }
            for (int kk = 0; kk < 8; ++kk) { const int k = kq * 8 + kk;
                __syncthreads();
                if (tid < 64) { const SsmLam L = ssm_lam(ap->in[18], ap->in[19], ap->in[20], g, tid); double wr_, wi_; ssm_pow(L, k, wr_, wi_); sW[tid * 2] = (float)wr_; sW[tid * 2 + 1] = (float)wi_; }
                __syncthreads();
                if (tid < 256) { const int c = tid >> 4, cp = tid & 15; float acc = 0.f;
                    for (int p = 0; p < 64; ++p) { const float cr = sC[(c * 64 + p) * 2], ci = sC[(c * 64 + p) * 2 + 1], wr_ = sW[p * 2], wi_ = sW[p * 2 + 1], br = sB[(p * 16 + cp) * 2], bi = sB[(p * 16 + cp) * 2 + 1];
                        const float tr = cr * wr_ - ci * wi_, ti = cr * wi_ + ci * wr_; acc += tr * br - ti * bi; }
                    if (k == 0 && c == cp) acc += ap->in[25][g * 16 + c];
                    KTAB[((size_t)g * 64 + k) * 256 + tid] = acc; } }
            __syncthreads();
        }
    }
    } GRID_BAR();

#pragma clang loop unroll(disable)
    for (int sl = 0; sl < 4; ++sl) {
        const int layer = sl >> 1, f = sl & 1;
        if (sl == 1) {
            { PHASE_BEGIN();
            for (long i = gt; i < 32L * 15 * 1536 / 8; i += NGT) { const float* src = ap->in[2] + i * 8; *(u32x4*)(HISTB + i * 8) = pack8(*(const f32x4*)src, *(const f32x4*)(src + 4)); }
            { pg8::Gemm g{XB, WINE, DM, DM, DM}; pg8::TileOrder S; S.init(MT / 256, 8, G, bx); pg8::EpiZe E{ZP, UP, out}; pg8::gemm_phase(lds, g, S, E); }
            if (bx >= 64 && bx < 96) { pg8::Gemm g{AEXPK, WUQN, 1024, 1024, 1024}; pg8::TileOrder S; S.init(16, 2, 32, bx - 64); pg8::EpiPlain E{WQLAT, 512}; pg8::gemm_phase(lds, g, S, E); }
            if (bx >= 96) { pg8::Gemm g{WOUTO, AEXPV, 1024, DM, 1024}; pg8::TileOrder S; S.init(8, 16, 160, bx - 96); pg8::EpiPlain E{WMIXS, 5120}; pg8::gemm_phase(lds, g, S, E); }
            } GRID_BAR(); { PHASE_BEGIN();
            { pg8::Gemm g{UP, BT1, 1024, 1152, 1024}; pg8::GroupOrder S; S.init(32, 3, 1, 3, 1, G, bx); pg8::EpiS1 E{S1}; pg8::gemm_phase(lds, g, S, E); }
            for (int it = NGW - 1 - gw; it < 2176 * 3; it += NGW) {
                const int rb = it / 3, cg = it % 3, col = cg * 512 + lane * 8, pg = col / 384, w = 2 << pg, wmax = 4 << cg;
                const int row0 = rb * 16; const bool smp = row0 >= MP; const int t0 = smp ? ((row0 - MP) & 63) : (row0 & (SEQ - 1)); const int rowb = row0 - t0;
                const bf16_t* zb = ZP + (size_t)rowb * 1536 + col; bf16_t* dp = DP + ((size_t)pg * MT + row0) * 384 + (col - pg * 384);
                const float icw = 1.f / (float)w;
                float sm[8];
#pragma unroll
                for (int e = 0; e < 8; ++e) sm[e] = 0.f;
#define UNPK(W_, F_) do { F_[0] = bflo(W_.x); F_[1] = bfhi(W_.x); F_[2] = bflo(W_.y); F_[3] = bfhi(W_.y); F_[4] = bflo(W_.z); F_[5] = bfhi(W_.z); F_[6] = bflo(W_.w); F_[7] = bfhi(W_.w); } while (0)
                const bf16_t* hb = HISTB + (size_t)(smp ? ((row0 - MP) >> 6) : 0) * 15 * 1536 + col; const bool early = !smp && t0 < 15;
#define ZSRC(tt_) ((tt_) >= 0 ? zb + (size_t)(tt_) * 1536 : hb + (size_t)(15 + (tt_)) * 1536)
                { u32x4 pz[15];
#pragma unroll
                    for (int k = 1; k < 16; ++k) { const int tt = t0 - (k < wmax ? k : 1); pz[k - 1] = *(const u32x4*)ZSRC(tt); }
#pragma unroll
                    for (int k = 1; k < 16; ++k) { float f[8]; UNPK(pz[k - 1], f); const float mk = (k < w && (smp || t0 - k >= 0)) ? 1.f : 0.f;
#pragma unroll
                        for (int e = 0; e < 8; ++e) sm[e] += mk * f[e]; }
#pragma unroll
                    for (int r8 = 0; r8 < 16; r8 += 8) { u32x4 za[8], ya[8];
#pragma unroll
                        for (int i = 0; i < 8; ++i) { const int t = t0 + r8 + i, ty = t - w + 1; za[i] = *(const u32x4*)(zb + (size_t)t * 1536); ya[i] = *(const u32x4*)ZSRC(ty); }
#pragma unroll
                        for (int i = 0; i < 8; ++i) { float f[8], y[8]; UNPK(za[i], f); UNPK(ya[i], y); const int t = t0 + r8 + i;
                            const float ic = (early && t + 1 < w) ? __builtin_amdgcn_rcpf((float)(t + 1)) : icw, my = (smp || t - w + 1 >= 0) ? 1.f : 0.f;
#pragma unroll
                            for (int e = 0; e < 8; ++e) sm[e] += f[e];
                            *(u32x4*)(dp + (size_t)(r8 + i) * 384) = pack8((f32x4){sm[0] * ic - f[0], sm[1] * ic - f[1], sm[2] * ic - f[2], sm[3] * ic - f[3]}, (f32x4){sm[4] * ic - f[4], sm[5] * ic - f[5], sm[6] * ic - f[6], sm[7] * ic - f[7]});
#pragma unroll
                            for (int e = 0; e < 8; ++e) sm[e] -= my * y[e]; } }
                }
#undef ZSRC
#undef UNPK
            }
            } GRID_BAR(); { PHASE_BEGIN();
            if (wave == 0 && bx >= G - 64) {
                const int cb_ = bx - (G - 64), b = cb_ >> 5, g = cb_ & 31, p = lane; const float ar = A64[(g * 64 + p) * 2], ai = A64[(g * 64 + p) * 2 + 1];
                float hr = 0.f, hi_ = 0.f;
                for (int kb = 0; kb < 256; kb += 16) { float sr[16], si[16];
#pragma unroll
                    for (int j = 0; j < 16; ++j) { const size_t row = (size_t)g * 768 + b * 256 + kb + j; sr[j] = S1[row * 128 + p]; si[j] = S1[row * 128 + 64 + p]; }
#pragma unroll
                    for (int j = 0; j < 16; ++j) { const size_t row = (size_t)g * 768 + b * 256 + kb + j;
                        UP[row * 1152 + 1024 + p] = (bf16_t)f2bf(hr); UP[row * 1152 + 1088 + p] = (bf16_t)f2bf(hi_);
                        const float nr = ar * hr - ai * hi_ + sr[j], ni = ar * hi_ + ai * hr + si[j]; hr = nr; hi_ = ni; } }
                out[O_SREP + (size_t)(b * 32 + g) * 64 + p] = hr; out[O_SIMP + (size_t)(b * 32 + g) * 64 + p] = hi_;
            } else if (bx >= 64 && bx < G - 64) {
                const int it = (bx - 64) * NW + wave;
                if (it < 1024) { const int b = it >> 5, g = it & 31, p = lane; const float ar = A64[(g * 64 + p) * 2], ai = A64[(g * 64 + p) * 2 + 1];
                    const float hr = ap->in[3][(size_t)(b * 32 + g) * 64 + p], hi_ = ap->in[4][(size_t)(b * 32 + g) * 64 + p]; const size_t row = (size_t)g * 768 + 512 + b;
                    UP[row * 1152 + 1024 + p] = (bf16_t)f2bf(hr); UP[row * 1152 + 1088 + p] = (bf16_t)f2bf(hi_);
                    const float sr = S1[row * 128 + p], si = S1[row * 128 + 64 + p];
                    out[O_SRES + (size_t)(b * 32 + g) * 64 + p] = ar * hr - ai * hi_ + sr; out[O_SIMS + (size_t)(b * 32 + g) * 64 + p] = ar * hi_ + ai * hr + si; }
            }
            { pg8::Gemm g{DP, WPOOL, 384, 384, 384}; pg8::GroupOrder S;
              if (G != 256) S.init(4, MT / 256, 2, MT / 256, 2, G, bx);
              else if (bx < 192) { S.init(4, MT / 256, 2, MT / 256, 2, 192, bx); S.total = 960; }
              else S.init(4, MT / 256, 2, MT / 256, 2, 64, 960 + bx - 192);
              pg8::EpiPool E{MIX, ap->in[17]}; pg8::gemm_phase(lds, g, S, E); }
            } GRID_BAR(); { PHASE_BEGIN();
            { pg8::Gemm g{UP, BT2, 1152, 1152, 1152}; pg8::EpiS2 E{GACT};
              if (G == 256) { pg8::S5Order S; S.init(bx); pg8::gemm_phase(lds, g, S, E); }
              else { pg8::GroupOrder S; S.init(32, 3, 4, 3, 4, G, bx); pg8::gemm_phase(lds, g, S, E); } }
            } GRID_BAR(); { PHASE_BEGIN();
            { pg8::Gemm g{GACT, WGLU, 512, 512, 512}; pg8::TileOrder S; S.init(MT / 256, 2, G, bx); pg8::EpiGlu E{GACT, ap->in[27], MIX}; pg8::gemm_phase(lds, g, S, E); }
            } GRID_BAR(); { PHASE_BEGIN();
            { pg8::Gemm g{MIX, WOUTE, DM, DM, DM}; pg8::SplitOrder S; S.init(MP / 256, MS / 256, 8, MP / 256, DM / 256, G, bx); pg8::EpiResid E{XB, TB, 1.f, 0, PART}; pg8::gemm_phase(lds, g, S, E); }
            } GRID_BAR();
        }
        if (sl == 3) {
            { PHASE_BEGIN();
            { pg8::Gemm g{XB, WINO, DM, DM, DM}; pg8::TileOrder S; S.init(MT / 256, 12, G, bx); pg8::EpiZo E{ZQ, ZC, ZK, UB, VPRE}; pg8::gemm_phase(lds, g, S, E); }
            } GRID_BAR(); { PHASE_BEGIN();
            for (long i0 = gt; i0 < 32L * 4096 * 36; i0 += 4 * NGT) {
                f32x4 ca[4], cb[4];
#pragma unroll
                for (int k = 0; k < 4; ++k) { const long i = i0 + k * NGT; if (i < 32L * 4096 * 36) { const int ch = (int)(i % 36); const long rowc = i / 36;
                    const float* src = ch < 32 ? ap->in[5] + (size_t)rowc * 256 + ch * 8 : ap->in[6] + (size_t)rowc * 32 + (ch - 32) * 8; ca[k] = *(const f32x4*)src; cb[k] = *(const f32x4*)(src + 4); } else { ca[k] = f32x4{}; cb[k] = f32x4{}; } }
#pragma unroll
                for (int k = 0; k < 4; ++k) { const long i = i0 + k * NGT; if (i < 32L * 4096 * 36) { const int ch = (int)(i % 36); const long rowc = i / 36; const int b = (int)(rowc >> 12), t = (int)(rowc & 4095);
                    *(u32x4*)(KXS + ((size_t)b * 4160 + t) * 288 + ch * 8) = pack8(ca[k], cb[k]); } }
            }
            const f32x4 gq0 = *(const f32x4*)(ap->in[30] + 4 * lane), gq1 = *(const f32x4*)(ap->in[30] + 256 + 4 * lane), gkv = *(const f32x4*)(ap->in[31] + 4 * lane);
            f32x4 gv[4], bv[4];
#pragma unroll
            for (int hf = 0; hf < 2; ++hf) { const int c0 = hf * 512 + 8 * lane; gv[2 * hf] = *(const f32x4*)(ap->in[35] + c0); gv[2 * hf + 1] = *(const f32x4*)(ap->in[35] + c0 + 4); bv[2 * hf] = *(const f32x4*)(ap->in[36] + c0); bv[2 * hf + 1] = *(const f32x4*)(ap->in[36] + c0 + 4); }
            for (int row = gw; row < MT; row += NGW) {
                const bool smp = row >= MP; const int rs = row - MP, sb = rs >> 6, st = rs & 63; const int pos = smp ? 4096 + st : (row & (SEQ - 1));
                bf16_t* kx = KXS + ((size_t)sb * 4160 + 4096 + st) * 288;
                const float* zq = ZQ + (size_t)row * 512; const f32x4 q0 = *(const f32x4*)(zq + 4 * lane), q1 = *(const f32x4*)(zq + 256 + 4 * lane);
                const f32x4 cv = *(const f32x4*)(ZC + (size_t)row * 256 + 4 * lane);
                const bf16_t* zv = VPRE + (size_t)row * 1024; const u32x4 wa = *(const u32x4*)(zv + 8 * lane), wb = *(const u32x4*)(zv + 512 + 8 * lane);
                float x1 = 0.f, x2 = 0.f, cs = 0.f, sn = 0.f;
                if (lane < 16) { x1 = ZK[(size_t)row * 32 + lane]; x2 = ZK[(size_t)row * 32 + 16 + lane]; cs = ROPE[(size_t)pos * 32 + lane]; sn = ROPE[(size_t)pos * 32 + 16 + lane]; }
                float v[16] = {bflo(wa.x), bfhi(wa.x), bflo(wa.y), bfhi(wa.y), bflo(wa.z), bfhi(wa.z), bflo(wa.w), bfhi(wa.w), bflo(wb.x), bfhi(wb.x), bflo(wb.y), bfhi(wb.y), bflo(wb.z), bfhi(wb.z), bflo(wb.w), bfhi(wb.w)};
                float ssq = (q0[0] * q0[0] + q0[1] * q0[1]) + (q0[2] * q0[2] + q0[3] * q0[3]) + (q1[0] * q1[0] + q1[1] * q1[1]) + (q1[2] * q1[2] + q1[3] * q1[3]);
                float ssc = (cv[0] * cv[0] + cv[1] * cv[1]) + (cv[2] * cv[2] + cv[3] * cv[3]);
                float sv = 0.f;
#pragma unroll
                for (int e = 0; e < 16; ++e) sv += v[e];
                ssq = wave_sum(ssq); ssc = wave_sum(ssc); sv = wave_sum(sv);
                const float mu = sv * (1.f / 1024); float s2 = 0.f;
#pragma unroll
                for (int e = 0; e < 16; ++e) { v[e] -= mu; s2 += v[e] * v[e]; }
                { const float r = 1.f / sqrtf(ssq * (1.f / 512) + RMS_EPS);
                  const f32x4 o0 = q0 * r * gq0, o1 = q1 * r * gq1; u32x2 w0, w1; w0.x = pk2(o0[0], o0[1]); w0.y = pk2(o0[2], o0[3]); w1.x = pk2(o1[0], o1[1]); w1.y = pk2(o1[2], o1[3]);
                  *(u32x2*)(CQN + (size_t)row * 512 + 4 * lane) = w0; *(u32x2*)(CQN + (size_t)row * 512 + 256 + 4 * lane) = w1; }
                { const float r = 1.f / sqrtf(ssc * (1.f / 256) + RMS_EPS); const f32x4 o = cv * r * gkv;
                  *(f32x4*)(out + (smp ? O_CKVS + (size_t)rs * 256 : O_CKVP + (size_t)row * 256) + 4 * lane) = o;
                  u32x2 w; w.x = pk2(o[0], o[1]); w.y = pk2(o[2], o[3]); *(u32x2*)((smp ? kx : CKVB + (size_t)row * 256) + 4 * lane) = w; }
                if (lane < 16) {
                  const float o1 = x1 * cs - x2 * sn, o2 = x2 * cs + x1 * sn; float* op = out + (smp ? O_KPES + (size_t)rs * 32 : O_KPEP + (size_t)row * 32); op[lane] = o1; op[16 + lane] = o2;
                  bf16_t* kb = smp ? kx + 256 : KPEB + (size_t)row * 32; kb[lane] = (bf16_t)f2bf(o1); kb[16 + lane] = (bf16_t)f2bf(o2); }
                { const float r = 1.f / sqrtf(wave_sum(s2) * (1.f / 1024) + LN_EPS);
#pragma unroll
                  for (int hf = 0; hf < 2; ++hf) { const int c0 = hf * 512 + 8 * lane; const f32x4 g0 = gv[2 * hf], g1 = gv[2 * hf + 1], b0 = bv[2 * hf], b1 = bv[2 * hf + 1];
                      const f32x4 o0 = (f32x4){v[hf * 8 + 0], v[hf * 8 + 1], v[hf * 8 + 2], v[hf * 8 + 3]} * r * g0 + b0, o1 = (f32x4){v[hf * 8 + 4], v[hf * 8 + 5], v[hf * 8 + 6], v[hf * 8 + 7]} * r * g1 + b1;
                      *(u32x4*)(VB + (size_t)row * 1024 + c0) = pack8(o0, o1);
                      if (smp) { float* op = out + O_SGVS + (size_t)rs * 1024 + c0; *(f32x4*)op = o0; *(f32x4*)(op + 4) = o1; } } }
            }
            } GRID_BAR(); { PHASE_BEGIN();
            { pg8::Gemm g{CQN, WUQ, 512, 512, 512}; pg8::TileOrder S; S.init(MP / 256, 6, G, bx); pg8::EpiQ E{QP, QS, ROPE}; pg8::gemm_phase(lds, g, S, E); }
            { pg8::Gemm g{CQN, WUQ, 512, 512, 512}; pg8::TileOrder S; S.init(MS / 256, 2, G, bx, MP / 256, 4); pg8::EpiQ E{QP, QS, ROPE}; pg8::gemm_phase(lds, g, S, E); }
            { pg8::Gemm g{CQN + (size_t)MP * 512, WQLAT, 512, 512, 512}; pg8::TileOrder S; S.init(MS / 256, 16, G, bx >= G / 2 ? bx - G / 2 : bx + G / 2); pg8::EpiQlat E{QS}; pg8::gemm_phase(lds, g, S, E); }
            { pg8::Gemm g{CKVB, WKV, 256, 256, 256}; pg8::TileOrder S; S.init(MP / 256, 8, G, bx); pg8::EpiKV E{KP, VP}; pg8::gemm_phase(lds, g, S, E); }
            {
                constexpr int RS = 320, IMG = 128 * RS;
                char* sl = (char*)lds_raw;
                const int tb = wave >> 1, cbp = wave & 1, r32 = lane & 31, hi = lane >> 5;
                const int vrd = (int)(unsigned)(uintptr_t)sl + (8 * hi + ((lane >> 2) & 3)) * RS + (64 * cbp + 16 * ((lane >> 4) & 1) + 4 * (lane & 3)) * 2;
                u32x4 sv[4];
#define SG_LOAD(un_) do { const bool smp_ = (un_) >= 2048; const int ch_ = smp_ ? ((un_) - 2048) >> 3 : (un_) >> 3, g_ = (un_) & 7, rb_ = smp_ ? MP + ch_ * 64 : ch_ * 128, nr_ = smp_ ? 64 : 128; \
                    _Pragma("unroll") for (int k = 0; k < 4; ++k) { const int idx = tid + 512 * k, row = (idx >> 4) & (nr_ - 1); sv[k] = *(const u32x4*)(VB + (size_t)(rb_ + row) * 1024 + g_ * 128 + (idx & 15) * 8); } } while (0)
#define SG_WRITE(bf_) do { _Pragma("unroll") for (int k = 0; k < 4; ++k) { const int idx = tid + 512 * k, row = idx >> 4; *(u32x4*)(sl + (bf_) * IMG + row * RS + (idx & 15) * 16) = sv[k]; } } while (0)
                __syncthreads();
                int un = vcu, bf = 0;
                SG_LOAD(un); SG_WRITE(0);
                __syncthreads();
                for (; un < 2048 + 256; un += G, bf ^= 1) {
                    const int unn = un + G; const bool more = unn < 2048 + 256;
                    { const int unl = more ? unn : un; SG_LOAD(unl); }
                    const bool smp = un >= 2048; const int ch = smp ? (un - 2048) >> 3 : un >> 3, g = un & 7; const int rowbase = smp ? MP + ch * 64 : ch * 128;
                    if (!(smp && tb >= 2)) {
                        f32x16 c0 = f32x16{}, c1 = f32x16{};
                        const int nks = 2 * (tb + 1); const int vb = vrd + bf * IMG;
                        const bf16_t* wp = WSG + ((size_t)g * 128 + 32 * tb + r32) * 128 + 8 * hi;
                        for (int ks = 0; ks < nks; ++ks) {
                            const bf16x8 wf = *(const bf16x8*)(wp + 16 * ks);
                            const int va = vb + ks * 16 * RS;
                            const s16x4 l0 = att::tr_read<0>(va), h0 = att::tr_read<4 * RS>(va), l1 = att::tr_read<64>(va), h1 = att::tr_read<4 * RS + 64>(va);
                            asm volatile("s_waitcnt lgkmcnt(0)" ::: "memory"); __builtin_amdgcn_sched_barrier(0);
#define PK(L, H) (bf16x8){L[0], L[1], L[2], L[3], H[0], H[1], H[2], H[3]}
                            c0 = __builtin_amdgcn_mfma_f32_32x32x16_bf16(PK(l0, h0), wf, c0, 0, 0, 0); c1 = __builtin_amdgcn_mfma_f32_32x32x16_bf16(PK(l1, h1), wf, c1, 0, 0, 0);
#undef PK
                        }
                        const int t = 32 * tb + r32; const float bs = ap->in[38][g * 128 + t]; const size_t row = (size_t)(rowbase + t);
                        const bf16_t* up = UB + row * 1024 + g * 128 + 64 * cbp + 4 * hi;
                        bf16_t* op = (smp ? AS + (size_t)(row - MP) * 5120 + 4096 : MIX + row * DM + 1024) + g * 128 + 64 * cbp + 4 * hi;
#pragma unroll
                        for (int i = 0; i < 4; ++i) {
                            const u32x2 ua = *(const u32x2*)(up + 8 * i), ub = *(const u32x2*)(up + 32 + 8 * i); u32x2 oa, ob;
                            oa.x = pk2((c0[4 * i + 0] + bs) * bflo(ua.x), (c0[4 * i + 1] + bs) * bfhi(ua.x)); oa.y = pk2((c0[4 * i + 2] + bs) * bflo(ua.y), (c0[4 * i + 3] + bs) * bfhi(ua.y));
                            ob.x = pk2((c1[4 * i + 0] + bs) * bflo(ub.x), (c1[4 * i + 1] + bs) * bfhi(ub.x)); ob.y = pk2((c1[4 * i + 2] + bs) * bflo(ub.y), (c1[4 * i + 3] + bs) * bfhi(ub.y));
                            *(u32x2*)(op + 8 * i) = oa; *(u32x2*)(op + 32 + 8 * i) = ob; }
                    }
                    SG_WRITE(bf ^ 1);
                    __syncthreads();
                }
#undef SG_LOAD
#undef SG_WRITE
            }
            } GRID_BAR(); { PHASE_BEGIN();
            {
                char* ldsg = (char*)lds_raw;
                const int r32 = lane & 31, hi = lane >> 5;
                { const int bh = vcu >> 3, s = vcu & 7, b = bh >> 4, h = bh & 15;
                  for (int i = 0; i < 8; ++i) { const int x = s + 8 * (i >> 1), qb = (i & 1) ? 63 - x : x; const size_t rb = (size_t)b * SEQ;
                      const size_t qrow = rb + (size_t)qb * 256 + wave * 32;
                      att::attn_unit_p2(ldsg, QP + (qrow + r32) * 1536 + h * 96 + hi * 8, KP + rb * 1024 + h * 64, KPEB + rb * 32, VP + rb * 1024 + h * 64, 4 * (qb + 1), 4 * qb + (wave >> 1), MIX + qrow * DM + h * 64, DM); } }
                { const int b = vcu >> 3, hp = vcu & 7, wq = wave & 3, wd = wave >> 2, head = 2 * hp + (wq >> 1); const size_t srow0 = (size_t)b * 64 + 32 * (wq & 1);
                  att::attn_unit<true>(ldsg, QS + (srow0 + r32) * 4608 + head * 288 + hi * 8, KXS + (size_t)b * 4160 * 288, nullptr, 65, 1 << 30,
                                       AS + srow0 * 5120 + head * 256 + 128 * wd, 5120, 4 * wd); }
            }
            } GRID_BAR(); { PHASE_BEGIN();
            { pg8::Gemm g{MIX, WOUTO, DM, DM, DM}; pg8::TileOrder S; S.init(MP / 256, 8, G, bx); pg8::EpiResid E{XB, TB, 1.f, 0, PART}; pg8::gemm_phase(lds, g, S, E); }
            { pg8::Gemm g{AS, WMIXS, 5120, 5120, 5120}; pg8::SplitOrder S; S.init(0, MS / 256, 8, 0, 5120 / 256, G, bx); pg8::EpiResid E{XB, TB, 1.f, MP, PART}; pg8::gemm_phase(lds, g, S, E); }
            } GRID_BAR();
        }
        if (sl == 1 || sl == 3) {
            { PHASE_BEGIN();
            ln_pass(TB, XB, nullptr, PART, 1.f, ap->in[7] + (size_t)(layer * 3 + 1) * DM, ap->in[8] + (size_t)(layer * 3 + 1) * DM, gw, NGW, lane);
            } GRID_BAR();
        }
        { PHASE_BEGIN();
        { pg8::Gemm g{XB, WUP + (size_t)sl * 11264 * DM, DM, DM, DM}; pg8::TileOrder S; S.init(MT / 256, 44, G, bx); pg8::EpiSwiglu E{HB}; pg8::gemm_phase(lds, g, S, E); }
        if (sl < 3 && bx >= 96) {
            const int idx = sl + 1, l2 = idx >> 1, f2 = idx & 1, lw = (bx - 96) * NW + wave, nlw = (G - 96) * NW;
            const GAS float* w1 = (const GAS float*)(ap->in[9 + 3 * f2] + (size_t)l2 * DM * FF); const GAS float* w3 = (const GAS float*)(ap->in[10 + 3 * f2] + (size_t)l2 * DM * FF); const GAS float* w2 = (const GAS float*)(ap->in[11 + 3 * f2] + (size_t)l2 * FF * DM);
            GAS bf16_t* du = (GAS bf16_t*)(WUP + (size_t)idx * 11264 * DM); GAS bf16_t* dd = (GAS bf16_t*)(WDN + (size_t)idx * DM * FF);
            for (int it = lw; it < 3 * 704; it += nlw) {
                if (it < 704) transpose_item(w1, DM, FF, du, DM, 0, 1, 0, it, lane);
                else if (it < 1408) transpose_item(w3, DM, FF, du, DM, 0, 1, 128, it - 704, lane);
                else transpose_item(w2, FF, DM, dd, FF, 0, 0, 0, it - 1408, lane); }
        }
        } GRID_BAR(); { PHASE_BEGIN();
        { pg8::Gemm g{HB, WDN + (size_t)sl * DM * FF, FF, FF, FF}; pg8::SplitOrder S; S.init(MP / 256, MS / 256, 8, MP / 256, FF / 256, G, bx);
          pg8::EpiResid E{XB, sl == 3 ? TFIN : TB, 0.5f, 0, PART}; pg8::gemm_phase(lds, g, S, E); }
        } GRID_BAR(); { PHASE_BEGIN();
            ln_pass(sl == 3 ? TFIN : TB, XB, sl == 3 ? out : nullptr, PART, 0.5f, ap->in[7] + (size_t)(layer * 3 + 2 * f) * DM, ap->in[8] + (size_t)(layer * 3 + 2 * f) * DM, gw, NGW, lane);
            if (sl == 0) {
                for (long i = gt; i < 32L * 1024 * 128; i += NGT) { const int kc = (int)(i & 127), n = (int)((i >> 7) & 1023), g = (int)(i >> 17); const int j = n >> 4, c = n & 15, ii = 63 - (kc >> 1), cp = (kc & 1) * 8;
                    u32x4 w = (u32x4){0u, 0u, 0u, 0u};
                    if (ii <= j) { const float* kt = KTAB + ((size_t)g * 64 + (j - ii)) * 256 + c * 16 + cp; w = pack8(*(const f32x4*)kt, *(const f32x4*)(kt + 4)); }
                    *(u32x4*)(BT2 + ((size_t)g * 1024 + n) * 1152 + kc * 8) = w; }
            }
        } GRID_BAR();
    }
}

extern "C" void kernel_launch(void* const* d_in, const int* in_sizes, int n_in, void* d_out, int out_size, void* d_ws, size_t ws_size, hipStream_t stream) {
    static int grid = 0;
    if (grid == 0) {
        if (n_in != 40 || ws_size < WS_END) { fprintf(stderr, "kernel_launch: expected 40 inputs and >= %zu bytes of workspace; got %d, %zu\n", (size_t)WS_END, n_in, ws_size); grid = -1; return; }
        int dev = 0, cus = 0, per_cu = 0;
        if (hipGetDevice(&dev) != hipSuccess || hipDeviceGetAttribute(&cus, hipDeviceAttributeMultiprocessorCount, dev) != hipSuccess) { grid = -1; return; }
        if (hipFuncSetAttribute((const void*)fwd_kernel, hipFuncAttributeMaxDynamicSharedMemorySize, LDS_BYTES) != hipSuccess) { fprintf(stderr, "kernel_launch: hipFuncSetAttribute failed\n"); grid = -1; return; }
        if (hipOccupancyMaxActiveBlocksPerMultiprocessor(&per_cu, (const void*)fwd_kernel, NW * 64, LDS_BYTES) != hipSuccess || per_cu < 1) fprintf(stderr, "kernel_launch: occupancy query reports %d\n", per_cu);
        (void)hipGetLastError();
        grid = cus;
    }
    if (grid < 0) return;
    (void)hipMemsetAsync((char*)d_ws + WS_CTL, 0, CTL_ZERO_BYTES, stream);
    Args a{};
    for (int i = 0; i < 40; ++i) a.in[i] = (const float*)d_in[i];
    a.out = (float*)d_out; a.ws = (unsigned char*)d_ws;
    hipLaunchKernelGGL(fwd_kernel, dim3(grid), dim3(NW * 64), LDS_BYTES, stream, a);
    const hipError_t le = hipPeekAtLastError();
    if (le != hipSuccess) fprintf(stderr, "kernel_launch: launch failed: %s\n", hipGetErrorName(le));
}
```

```cpp
#include <hip/hip_runtime.h>
#include <cstdio>
#include <cstdint>

#define LAS __attribute__((address_space(3)))
#define GAS __attribute__((address_space(1)))
typedef unsigned short bf16_t;
typedef short bf16x8 __attribute__((ext_vector_type(8)));
typedef short s16x4 __attribute__((ext_vector_type(4)));
typedef float f32x4 __attribute__((ext_vector_type(4)));
typedef float f32x16 __attribute__((ext_vector_type(16)));
typedef unsigned u32x4 __attribute__((ext_vector_type(4)));
typedef unsigned u32x2 __attribute__((ext_vector_type(2)));

constexpr int DM = 2048, SEQ = 16384, MP = 2 * SEQ, MS = 32 * 64, MT = MP + MS, FF = 5632;
constexpr float ALPHA = 1.4142135623730951f;
constexpr float LN_EPS = 1e-5f, RMS_EPS = 1e-6f;
constexpr float C2 = 0.10206207261596575f * 1.4426950408889634f;
constexpr int NW = 8;

constexpr size_t O_YP = 0, O_YS = 67108864, O_POOLP = 71303168, O_SREP = 71349248, O_SIMP = 71353344, O_CKVP = 71357440, O_KPEP = 79746048,
                 O_POOLS = 80794624, O_SRES = 81531904, O_SIMS = 81597440, O_CKVS = 81662976, O_KPES = 82187264, O_SGVS = 82252800;

constexpr size_t MiB = 1u << 20;
constexpr size_t WS_CTL = 0, CTL_ZERO_BYTES = 32768;
constexpr size_t WS_ROPE = 1 * MiB, WS_KTAB = 3 * MiB, WS_A64 = 5 * MiB;
constexpr size_t WS_WUP = 8 * MiB, WS_WDN = 184 * MiB;
constexpr size_t WS_WINE = 272 * MiB, WS_WOUTE = 280 * MiB, WS_WINO = 288 * MiB, WS_WOUTO = 300 * MiB, WS_WMIXS = 308 * MiB, WS_AEXPK = 328 * MiB, WS_AEXPV = 336 * MiB,
                 WS_WQLAT = 344 * MiB, WS_WPOOL = 348 * MiB, WS_WUQ = 350 * MiB, WS_WKV = 352 * MiB, WS_WUQN = 353 * MiB, WS_WGLU = 354 * MiB, WS_WSG = 355 * MiB;
constexpr size_t WS_BT1 = 356 * MiB, WS_BT2 = 372 * MiB;
constexpr size_t WS_XB = 444 * MiB;
constexpr size_t WS_SCR = 580 * MiB;
constexpr size_t WS_H = WS_SCR;
constexpr size_t WS_ZP = 580 * MiB, WS_DP = 682 * MiB, WS_UP = 784 * MiB, WS_S1 = 838 * MiB, WS_GACT = 850 * MiB;
constexpr size_t WS_ZQ = 580 * MiB, WS_ZC = 648 * MiB, WS_ZK = 682 * MiB, WS_UB = 688 * MiB, WS_VPRE = 756 * MiB, WS_VB = 824 * MiB, WS_CQN = 892 * MiB, WS_CKVB = 926 * MiB,
                 WS_KPEB = 942 * MiB, WS_AS = 756 * MiB;
constexpr size_t WS_PART = 954 * MiB;
constexpr size_t WS_KP = 580 * MiB;
constexpr size_t WS_QP = 8 * MiB, WS_QS = 104 * MiB, WS_VP = 184 * MiB, WS_KXS = 356 * MiB;
constexpr size_t WS_END = 1024 * MiB;

constexpr int CW_TMO = 0, CW_BAR = 4096;
constexpr int LDS_BYTES = 147456, LDSCTL_OFF = 147456 - 256;

__device__ __forceinline__ unsigned f2bf(float f) { unsigned u = __builtin_bit_cast(unsigned, f); return (u + 0x7fffu + ((u >> 16) & 1u)) >> 16; }
typedef float f32x2_t __attribute__((ext_vector_type(2))); typedef __bf16 bf16x2_t __attribute__((ext_vector_type(2)));
__device__ __forceinline__ unsigned pk2(float lo, float hi) { const f32x2_t v = {lo, hi}; const bf16x2_t b = __builtin_convertvector(v, bf16x2_t); return __builtin_bit_cast(unsigned, b); }
__device__ __forceinline__ float bf2f(unsigned short u) { return __builtin_bit_cast(float, (unsigned)u << 16); }
__device__ __forceinline__ float bflo(unsigned w) { return __builtin_bit_cast(float, w << 16); }
__device__ __forceinline__ float bfhi(unsigned w) { return __builtin_bit_cast(float, w & 0xffff0000u); }
__device__ __forceinline__ void half_swap(float x, float& lo, float& hi) {
    unsigned a = __builtin_bit_cast(unsigned, x), b = a;
    asm volatile("s_nop 1\n\tv_permlane32_swap_b32 %0, %1\n\ts_nop 1" : "+v"(a), "+v"(b));
    lo = __builtin_bit_cast(float, a); hi = __builtin_bit_cast(float, b);
}
#define DPP_ADD(v, ctrl) v += __builtin_bit_cast(float, __builtin_amdgcn_update_dpp(0, __builtin_bit_cast(int, v), ctrl, 0xf, 0xf, false))
__device__ __forceinline__ float wave_sum(float v) {
    DPP_ADD(v, 0xB1); DPP_ADD(v, 0x4E); DPP_ADD(v, 0x141); DPP_ADD(v, 0x140);
    v += __builtin_bit_cast(float, __builtin_amdgcn_ds_swizzle(__builtin_bit_cast(int, v), (16 << 10) | 0x1f));
    float lo, hi; half_swap(v, lo, hi); return lo + hi;
}
__device__ __forceinline__ float ex2(float x) { return __builtin_amdgcn_exp2f(x); }
__device__ __forceinline__ float sigmoidf_(float x) { return __builtin_amdgcn_rcpf(1.f + ex2(-1.4426950408889634f * x)); }
__device__ __forceinline__ float siluf_(float x) { return x * sigmoidf_(x); }
__device__ __forceinline__ float gelu_tanh(float y) { const float z = 0.7978845608028654f * (y + 0.044715f * y * y * y); const float t = 1.f - 2.f * __builtin_amdgcn_rcpf(1.f + ex2(2.885390081777927f * z)); return 0.5f * y * (1.f + t); }
__device__ __forceinline__ u32x4 pack8(f32x4 a, f32x4 b) { u32x4 w; w.x = pk2(a[0], a[1]); w.y = pk2(a[2], a[3]); w.z = pk2(b[0], b[1]); w.w = pk2(b[2], b[3]); return w; }
__device__ __forceinline__ void dsincos(double x, double& s, double& c) {
    const double k = rint(x * 0.6366197723675814); const double y = x - k * 1.5707963267948966192;
    const double y2 = y * y;
    const double sy = y * (1.0 + y2 * (-1.0 / 6 + y2 * (1.0 / 120 + y2 * (-1.0 / 5040 + y2 * (1.0 / 362880 + y2 * (-1.0 / 39916800 + y2 * (1.0 / 6227020800.0)))))));
    const double cy = 1.0 + y2 * (-0.5 + y2 * (1.0 / 24 + y2 * (-1.0 / 720 + y2 * (1.0 / 40320 + y2 * (-1.0 / 3628800 + y2 * (1.0 / 479001600.0))))));
    const int q = ((int)(long long)k) & 3;
    s = (q == 0) ? sy : (q == 1) ? cy : (q == 2) ? -sy : -cy;
    c = (q == 0) ? cy : (q == 1) ? -sy : (q == 2) ? -cy : sy;
}
__device__ __forceinline__ double dexp(double x) {
    const double n = rint(x * 1.4426950408889634); const double r = x - n * 0.6931471805599453094;
    double p = 1.0 / 479001600.0;
    p = p * r + 1.0 / 39916800; p = p * r + 1.0 / 3628800; p = p * r + 1.0 / 362880; p = p * r + 1.0 / 40320; p = p * r + 1.0 / 5040; p = p * r + 1.0 / 720;
    p = p * r + 1.0 / 120; p = p * r + 1.0 / 24; p = p * r + 1.0 / 6; p = p * r + 0.5; p = p * r + 1.0; p = p * r + 1.0;
    return ldexp(p, (int)n);
}

namespace pg8 {
constexpr int BM = 256, BK = 64, HALF = 128, HTB = HALF * BK * 2, NXCD = 8, WGM = 8;
__host__ __device__ __forceinline__ int lds_byte(int r, int c) { const int st = (r >> 4) * 2 + (c >> 5), rr = r & 15, cc = c & 31, ob = rr * 64 + cc * 2; return st * 1024 + (ob ^ (((ob >> 9) & 1) << 5)); }
__host__ __device__ __forceinline__ void stage_rc(int b, int& R, int& C) { const int st = b / 1024, sb = b % 1024, swz = sb ^ (((sb >> 9) & 1) << 5); R = (st >> 1) * 16 + swz / 64; C = (st & 1) * 32 + (swz % 64) / 2; }
__host__ __device__ __forceinline__ int perm32(int rho) { const int n = rho >> 4, i = rho & 15; return 8 * (i >> 2) + 4 * n + (i & 3); }

struct Unit { int pm, pn, g, lm, ln, kofs, nt; };
struct Gemm { const bf16_t* A; const bf16_t* Bt; int K, lda, ldb; };

struct TileOrder {
    int nM, nN, nwg, G, c, pm0, pn0;
    __device__ __forceinline__ void init(int nM_, int nN_, int G_, int c_, int pm0_ = 0, int pn0_ = 0) { nM = nM_; nN = nN_; nwg = nM * nN; G = G_; c = c_; pm0 = pm0_; pn0 = pn0_; }
    __device__ __forceinline__ bool next(int i, Unit& u) const {
        const long L = (long)i * G + c; if (L >= nwg) return false;
        int wgid = (int)L; { const int q = nwg / NXCD, r = nwg % NXCD, xcd = wgid % NXCD, off = wgid / NXCD; wgid = (xcd < r ? xcd * (q + 1) : r * (q + 1) + (xcd - r) * q) + off; }
        const int nig = WGM * nN, gid = wgid / nig, fm = gid * WGM, gsz = (nM - fm) < WGM ? (nM - fm) : WGM;
        const int pm = fm + ((wgid % nig) % gsz), pn = (wgid % nig) / gsz;
        u.pm = pm0 + pm; u.pn = pn0 + pn; u.g = 0; u.lm = pm; u.ln = pn; u.kofs = 0; u.nt = 0; return true;
    }
    __device__ __forceinline__ void a_ready(const Unit&) const {}
    __device__ __forceinline__ void done(const Unit&) const {}
};
struct SplitOrder {
    TileOrder T; int nfull, nsplit, nN, pms0, ntq, G, c;
    __device__ __forceinline__ void init(int nMf, int nMs, int nN_, int pms0_, int ntq_, int G_, int c_) { T.init(nMf, nN_, G_, c_); nfull = nMf * nN_; nsplit = nMs * nN_ * 4; nN = nN_; pms0 = pms0_; ntq = ntq_; G = G_; c = c_; }
    __device__ __forceinline__ bool next(int i, Unit& u) const {
        const long L = (long)i * G + c;
        if (L < nfull) return T.next(i, u);
        const int s_ = (int)(L - nfull); if (s_ >= nsplit) return false;
        const int kq = s_ & 3, tile = s_ >> 2, pm = tile / nN, pn = tile - pm * nN;
        u.pm = pms0 + pm; u.pn = pn; u.g = kq; u.lm = pm; u.ln = pn; u.kofs = kq * ntq * 64; u.nt = ntq; return true;
    }
    __device__ __forceinline__ void a_ready(const Unit&) const {}
    __device__ __forceinline__ void done(const Unit&) const {}
};
struct S5Order {
    int c;
    __device__ __forceinline__ void init(int c_) { c = c_; }
    __device__ __forceinline__ bool next(int i, Unit& u) const {
        int q, ln;
        if (c < 96) { if (i > 0) return false; q = c; ln = 3; }
        else if (c < 192) { if (i > 1) return false; q = c - 96; ln = i == 0 ? 2 : 0; }
        else if (c < 240) { if (i > 1) return false; q = 2 * (c - 192) + i; ln = 1; }
        else return false;
        const int g = q / 3, lm = q - 3 * g;
        u.pm = g * 3 + lm; u.pn = g * 4 + ln; u.g = g; u.lm = lm; u.ln = ln; u.kofs = 768 - 256 * ln; u.nt = 6 + 4 * ln; return true;
    }
    __device__ __forceinline__ void a_ready(const Unit&) const {}
    __device__ __forceinline__ void done(const Unit&) const {}
};
struct GroupOrder {
    int nMg, nNg, per, total, G, c, sA, sB;
    __device__ __forceinline__ void init(int ng, int nMg_, int nNg_, int sA_, int sB_, int G_, int c_) { nMg = nMg_; nNg = nNg_; per = nMg * nNg; total = ng * per; sA = sA_; sB = sB_; G = G_; c = c_; }
    __device__ __forceinline__ bool next(int i, Unit& u) const {
        const long L = (long)i * G + c; if (L >= total) return false;
        const int g = (int)L / per, r = (int)L % per, lm = r / nNg, ln = r % nNg;
        u.pm = g * sA + lm; u.pn = g * sB + ln; u.g = g; u.lm = lm; u.ln = ln; u.kofs = 0; u.nt = 0; return true;
    }
    __device__ __forceinline__ void a_ready(const Unit&) const {}
    __device__ __forceinline__ void done(const Unit&) const {}
};

template <class Epi, class Sched>
__device__ __forceinline__ void gemm_phase(LAS unsigned char* lds, const Gemm g, const Sched& S, const Epi& E) {
    int tid_ = threadIdx.x; asm volatile("" : "+v"(tid_));
    const int tid = tid_, wid = __builtin_amdgcn_readfirstlane(tid >> 6), lane = tid & 63, wr = wid >> 2, wc = wid & 3, fr = lane & 15, fq = lane >> 4;
    int K_ = g.K; asm volatile("" : "+s"(K_)); const int K = K_, nt = K / BK;
    unsigned voffA[2], voffB[2];
#pragma unroll
    for (int i = 0; i < 2; ++i) { int R, C; stage_rc(tid * 16 + i * 8192, R, C); const int Rb = Epi::PERM ? ((R & ~31) + perm32(R & 31)) : R;
        voffA[i] = (unsigned)(R * g.lda + C) * 2u; voffB[i] = (unsigned)(Rb * g.ldb + C) * 2u; }
    const size_t kstep = (size_t)(BK * 2);
    const size_t hstepA = (size_t)HALF * g.lda * 2, hstepB = (size_t)HALF * g.ldb * 2;
    const size_t tstepA = 2 * hstepA, tstepB = 2 * hstepB;
    const unsigned ldsw = (unsigned)wid * 1024u;
    const int aoff = lds_byte(wr * 64 + fr, fq * 8), boff = lds_byte(wc * 32 + fr, fq * 8);
#define PG8_SA(b, h) (((b) * 2 + (h)) * HTB)
#define PG8_SB(b, h) ((4 + (b) * 2 + (h)) * HTB)
#define PG8_STAGE(bufoff, gbase, voff) do { _Pragma("unroll") for (int _i = 0; _i < 2; ++_i) \
        __builtin_amdgcn_global_load_lds((const unsigned*)((const char*)(gbase) + (voff)[_i]), (LAS unsigned*)(lds + (bufoff) + ldsw + _i * 8192), 16, 0, 0); } while (0)
#define PG8_LDA(dst, b, h) do { _Pragma("unroll") for (int m = 0; m < 4; ++m) _Pragma("unroll") for (int k = 0; k < 2; ++k) dst[m][k] = *(const LAS bf16x8*)(lds + PG8_SA(b, h) + aoff + m * 2048 + k * 1024); } while (0)
#define PG8_LDB(dst, b, h) do { _Pragma("unroll") for (int n = 0; n < 2; ++n) _Pragma("unroll") for (int k = 0; k < 2; ++k) dst[n][k] = *(const LAS bf16x8*)(lds + PG8_SB(b, h) + boff + n * 2048 + k * 1024); } while (0)
#define PG8_MMA(ai, bj, At, Bt) do { __builtin_amdgcn_s_setprio(1); _Pragma("unroll") for (int m = 0; m < 4; ++m) _Pragma("unroll") for (int n = 0; n < 2; ++n) _Pragma("unroll") for (int k = 0; k < 2; ++k) \
        acc[ai][bj][m][n] = __builtin_amdgcn_mfma_f32_16x16x32_bf16(Bt[n][k], At[m][k], acc[ai][bj][m][n], 0, 0, 0); __builtin_amdgcn_s_setprio(0); } while (0)
#define PG8_WAIT_V(n) asm volatile("s_waitcnt vmcnt(" #n ")" ::: "memory")
#define PG8_WAIT_L(n) asm volatile("s_waitcnt lgkmcnt(" #n ")" ::: "memory")
#define PG8_BAR __builtin_amdgcn_s_barrier()
#define PG8_SCHED __builtin_amdgcn_sched_barrier(0)
    Unit cur, nxt; int ui = 0;
    if (!S.next(0, cur)) return;
    f32x4 acc[2][2][4][2];
#pragma unroll
    for (int a = 0; a < 2; ++a)
#pragma unroll
        for (int b = 0; b < 2; ++b)
#pragma unroll
            for (int m = 0; m < 4; ++m)
#pragma unroll
                for (int n = 0; n < 2; ++n) acc[a][b][m][n] = (f32x4){0.f, 0.f, 0.f, 0.f};
    bf16x8 At[4][2], B0[2][2], B1[2][2];
    const char* cA = (const char*)g.A + (size_t)cur.pm * tstepA + (size_t)cur.kofs * 2; const char* cB = (const char*)g.Bt + (size_t)cur.pn * tstepB + (size_t)cur.kofs * 2;
    S.a_ready(cur);
    PG8_STAGE(PG8_SB(0, 0), cB, voffB); PG8_STAGE(PG8_SB(0, 1), cB + hstepB, voffB); PG8_STAGE(PG8_SA(0, 0), cA, voffA); PG8_STAGE(PG8_SA(0, 1), cA + hstepA, voffA);
    if (wr == 1) PG8_BAR;
    PG8_WAIT_V(2); PG8_BAR;
    PG8_STAGE(PG8_SB(1, 0), cB + kstep, voffB); PG8_STAGE(PG8_SA(1, 0), cA + kstep, voffA); PG8_STAGE(PG8_SB(1, 1), cB + hstepB + kstep, voffB);
    PG8_WAIT_V(6); PG8_BAR;
    for (;;) {
        const bool has_next = S.next(ui + 1, nxt);
        const char* nA = has_next ? (const char*)g.A + (size_t)nxt.pm * tstepA + (size_t)nxt.kofs * 2 : cA; const char* nB = has_next ? (const char*)g.Bt + (size_t)nxt.pn * tstepB + (size_t)nxt.kofs * 2 : cB;
        const int ntc = cur.nt ? cur.nt : nt;
#pragma clang loop unroll(disable)
        for (int t = 0; t < ntc; t += 2) {
            const bool last = (t == ntc - 2);
            const char* a1 = cA + (size_t)(t + 1) * kstep;
            const char* a2 = last ? nA : cA + (size_t)(t + 2) * kstep; const char* b2 = last ? nB : cB + (size_t)(t + 2) * kstep;
            const char* a3 = a2 + kstep; const char* b3 = b2 + kstep;
            if (last && has_next) S.a_ready(nxt);
            PG8_LDB(B0, 0, 0); PG8_LDB(B1, 0, 1); PG8_SCHED; PG8_LDA(At, 0, 0); PG8_STAGE(PG8_SA(1, 1), a1 + hstepA, voffA);
            PG8_WAIT_V(8); PG8_WAIT_L(0); PG8_BAR; PG8_MMA(0, 0, At, B0); PG8_MMA(0, 1, At, B1); PG8_BAR; PG8_SCHED;
            PG8_LDA(At, 0, 1); PG8_STAGE(PG8_SB(0, 0), b2, voffB); PG8_STAGE(PG8_SB(0, 1), b2 + hstepB, voffB); PG8_STAGE(PG8_SA(0, 0), a2, voffA);
            PG8_WAIT_V(8); PG8_WAIT_L(0); PG8_BAR; PG8_MMA(1, 0, At, B0); PG8_MMA(1, 1, At, B1); PG8_BAR; PG8_SCHED;
            PG8_LDB(B0, 1, 0); PG8_LDB(B1, 1, 1); PG8_SCHED; PG8_LDA(At, 1, 0); PG8_STAGE(PG8_SA(0, 1), a2 + hstepA, voffA);
            PG8_WAIT_V(8); PG8_WAIT_L(0); PG8_BAR; PG8_MMA(0, 0, At, B0); PG8_MMA(0, 1, At, B1); PG8_BAR; PG8_SCHED;
            PG8_LDA(At, 1, 1); PG8_STAGE(PG8_SB(1, 0), b3, voffB); PG8_STAGE(PG8_SB(1, 1), b3 + hstepB, voffB); PG8_STAGE(PG8_SA(1, 0), a3, voffA);
            PG8_WAIT_V(8); PG8_WAIT_L(0); PG8_BAR; PG8_MMA(1, 0, At, B0); PG8_MMA(1, 1, At, B1); PG8_BAR; PG8_SCHED;
        }
        if (wr == 0) PG8_BAR;
        E(acc, cur, wr, wc, fr, fq); S.done(cur);
        if (!has_next) break;
#pragma unroll
        for (int a = 0; a < 2; ++a)
#pragma unroll
            for (int b = 0; b < 2; ++b)
#pragma unroll
                for (int m = 0; m < 4; ++m)
#pragma unroll
                    for (int n = 0; n < 2; ++n) acc[a][b][m][n] = (f32x4){0.f, 0.f, 0.f, 0.f};
        cur = nxt; cA = nA; cB = nB; ++ui;
        if (wr == 1) PG8_BAR;
    }
    PG8_WAIT_V(0);
    PG8_BAR;
#undef PG8_SA
#undef PG8_SB
#undef PG8_STAGE
#undef PG8_LDA
#undef PG8_LDB
#undef PG8_MMA
#undef PG8_WAIT_V
#undef PG8_WAIT_L
#undef PG8_BAR
#undef PG8_SCHED
}

typedef const f32x4 (&AccRef)[2][2][4][2];

struct EpiSwiglu { static constexpr bool PERM = true; bf16_t* H;
    __device__ __forceinline__ void operator()(AccRef acc, const Unit& u, int wr, int wc, int fr, int fq) const {
        const int row0 = u.pm * 256 + wr * 64 + fr, col0 = u.pn * 128 + wc * 32 + 8 * fq;
#pragma unroll
        for (int ai = 0; ai < 2; ++ai)
#pragma unroll
            for (int m = 0; m < 4; ++m) { bf16_t* rowp = H + (size_t)(row0 + ai * 128 + m * 16) * FF + col0;
                f32x4 h0, h1;
#pragma unroll
                for (int e = 0; e < 4; ++e) { h0[e] = siluf_(acc[ai][0][m][0][e]) * acc[ai][1][m][0][e]; h1[e] = siluf_(acc[ai][0][m][1][e]) * acc[ai][1][m][1][e]; }
                *(u32x4*)rowp = pack8(h0, h1); }
    }
};
struct EpiResid { static constexpr bool PERM = true; const bf16_t* xsrc; bf16_t* tdst; float scale; int row_off; bf16_t* part;
    __device__ __forceinline__ void operator()(AccRef acc, const Unit& u, int wr, int wc, int fr, int fq) const {
        const int row0 = row_off + u.pm * 256 + wr * 64 + fr, col0 = u.pn * 256 + wc * 32 + 8 * fq;
        if (u.nt) {
#pragma unroll
            for (int ai = 0; ai < 2; ++ai)
#pragma unroll
                for (int m = 0; m < 4; ++m) { bf16_t* pp = part + ((size_t)u.g * MS + (row0 + ai * 128 + m * 16 - MP)) * DM + col0;
#pragma unroll
                    for (int bj = 0; bj < 2; ++bj) *(u32x4*)(pp + bj * 128) = pack8(acc[ai][bj][m][0], acc[ai][bj][m][1]); }
        } else {
#pragma unroll
            for (int ai = 0; ai < 2; ++ai)
#pragma unroll
                for (int m = 0; m < 4; ++m) { const size_t ro = (size_t)(row0 + ai * 128 + m * 16) * DM + col0;
#pragma unroll
                    for (int bj = 0; bj < 2; ++bj) { const u32x4 xw = *(const u32x4*)(xsrc + ro + bj * 128);
                        const f32x4 x0 = (f32x4){bflo(xw.x), bfhi(xw.x), bflo(xw.y), bfhi(xw.y)}, x1 = (f32x4){bflo(xw.z), bfhi(xw.z), bflo(xw.w), bfhi(xw.w)};
                        *(u32x4*)(tdst + ro + bj * 128) = pack8(x0 * ALPHA + acc[ai][bj][m][0] * scale, x1 * ALPHA + acc[ai][bj][m][1] * scale); } }
        }
    }
};
struct EpiZe { static constexpr bool PERM = true; bf16_t* ZP; bf16_t* UP; float* out;
    __device__ __forceinline__ void operator()(AccRef acc, const Unit& u, int wr, int wc, int fr, int fq) const {
        const int row0 = u.pm * 256 + wr * 64 + fr, col0 = u.pn * 256 + wc * 32 + 8 * fq;
#pragma unroll
        for (int ai = 0; ai < 2; ++ai)
#pragma unroll
            for (int m = 0; m < 4; ++m) { const int row = row0 + ai * 128 + m * 16;
#pragma unroll
                for (int bj = 0; bj < 2; ++bj) { const int col = col0 + bj * 128; const f32x4 v0 = acc[ai][bj][m][0], v1 = acc[ai][bj][m][1];
                    if (u.pn < 6) {
                        *(u32x4*)(ZP + (size_t)row * 1536 + col) = pack8(v0, v1);
                        float* op = nullptr;
                        if (row < MP) { const int t = row & (SEQ - 1); if (t >= SEQ - 15) op = out + O_POOLP + ((size_t)((row >> 14) * 15 + (t - (SEQ - 15))) * 1536 + col); }
                        else { const int rs = row - MP, t = rs & 63; if (t >= 49) op = out + O_POOLS + ((size_t)((rs >> 6) * 15 + (t - 49)) * 1536 + col); }
                        if (op) { *(f32x4*)op = v0; *(f32x4*)(op + 4) = v1; }
                    } else {
                        const int cs = col - 1536, g = cs >> 4, c8 = cs & 15;
                        const int chunkrow = row < MP ? (row >> 6) : 512 + ((row - MP) >> 6), i = row & 63;
                        *(u32x4*)(UP + ((size_t)g * 768 + chunkrow) * 1152 + (63 - i) * 16 + c8) = pack8(v0, v1);
                    } } }
    }
};
struct EpiS1 { static constexpr bool PERM = false; float* S1;
    __device__ __forceinline__ void operator()(AccRef acc, const Unit& u, int wr, int wc, int fr, int fq) const {
        const int row0 = u.lm * 256 + wr * 64 + fr, col0 = wc * 32 + 4 * fq;
#pragma unroll
        for (int ai = 0; ai < 2; ++ai)
#pragma unroll
            for (int m = 0; m < 4; ++m) { float* rp = S1 + ((size_t)u.g * 768 + row0 + ai * 128 + m * 16) * 128 + col0;
#pragma unroll
                for (int n = 0; n < 2; ++n) *(f32x4*)(rp + n * 16) = acc[ai][0][m][n]; }
    }
};
struct EpiPool { static constexpr bool PERM = true; bf16_t* MIX; const float* pscale;
    __device__ __forceinline__ void operator()(AccRef acc, const Unit& u, int wr, int wc, int fr, int fq) const {
        const int row0 = u.lm * 256 + wr * 64 + fr, col0 = u.ln * 256 + wc * 32 + 8 * fq;
#pragma unroll
        for (int bj = 0; bj < 2; ++bj) { const int col = col0 + bj * 128;
            if (col < 384) { const f32x4 s0 = *(const f32x4*)(pscale + u.g * 384 + col), s1 = *(const f32x4*)(pscale + u.g * 384 + col + 4);
#pragma unroll
                for (int ai = 0; ai < 2; ++ai)
#pragma unroll
                    for (int m = 0; m < 4; ++m) *(u32x4*)(MIX + (size_t)(row0 + ai * 128 + m * 16) * DM + u.g * 384 + col) = pack8(acc[ai][bj][m][0] * s0, acc[ai][bj][m][1] * s1); } }
    }
};
struct EpiS2 { static constexpr bool PERM = true; bf16_t* GACT;
    __device__ __forceinline__ void operator()(AccRef acc, const Unit& u, int wr, int wc, int fr, int fq) const {
        const int row0 = u.lm * 256 + wr * 64 + fr, col0 = u.ln * 256 + wc * 32 + 8 * fq;
#pragma unroll
        for (int ai = 0; ai < 2; ++ai)
#pragma unroll
            for (int m = 0; m < 4; ++m) { const int rl = row0 + ai * 128 + m * 16;
                if (rl < 544) {
#pragma unroll
                    for (int bj = 0; bj < 2; ++bj) { const int col = col0 + bj * 128, j = col >> 4, c8 = col & 15;
                        const int tok = rl < 512 ? rl * 64 + j : MP + (rl - 512) * 64 + j;
                        f32x4 a = acc[ai][bj][m][0], b = acc[ai][bj][m][1];
#pragma unroll
                        for (int e = 0; e < 4; ++e) { a[e] = gelu_tanh(a[e]); b[e] = gelu_tanh(b[e]); }
                        *(u32x4*)(GACT + (size_t)tok * 512 + u.g * 16 + c8) = pack8(a, b); } } }
    }
};
struct EpiGlu { static constexpr bool PERM = true; const bf16_t* GACT; const float* bglu; bf16_t* MIX;
    __device__ __forceinline__ void operator()(AccRef acc, const Unit& u, int wr, int wc, int fr, int fq) const {
        const int row0 = u.pm * 256 + wr * 64 + fr, col0 = u.pn * 256 + wc * 32 + 8 * fq;
#pragma unroll
        for (int bj = 0; bj < 2; ++bj) { const int col = col0 + bj * 128; const f32x4 b0 = *(const f32x4*)(bglu + col), b1 = *(const f32x4*)(bglu + col + 4);
#pragma unroll
            for (int ai = 0; ai < 2; ++ai)
#pragma unroll
                for (int m = 0; m < 4; ++m) { const int row = row0 + ai * 128 + m * 16; const u32x4 gw = *(const u32x4*)(GACT + (size_t)row * 512 + col);
                    const f32x4 g0 = (f32x4){bflo(gw.x), bfhi(gw.x), bflo(gw.y), bfhi(gw.y)}, g1 = (f32x4){bflo(gw.z), bfhi(gw.z), bflo(gw.w), bfhi(gw.w)};
                    f32x4 o0, o1;
#pragma unroll
                    for (int e = 0; e < 4; ++e) { o0[e] = g0[e] * sigmoidf_(acc[ai][bj][m][0][e] + b0[e]); o1[e] = g1[e] * sigmoidf_(acc[ai][bj][m][1][e] + b1[e]); }
                    *(u32x4*)(MIX + (size_t)row * DM + 1536 + col) = pack8(o0, o1); } }
    }
};
struct EpiZo { static constexpr bool PERM = true; float* ZQ; float* ZC; float* ZK; bf16_t* UB; bf16_t* VPRE;
    __device__ __forceinline__ void operator()(AccRef acc, const Unit& u, int wr, int wc, int fr, int fq) const {
        const int row0 = u.pm * 256 + wr * 64 + fr, cl0 = wc * 32 + 8 * fq;
#pragma unroll
        for (int ai = 0; ai < 2; ++ai)
#pragma unroll
            for (int m = 0; m < 4; ++m) { const size_t row = (size_t)(row0 + ai * 128 + m * 16);
#pragma unroll
                for (int bj = 0; bj < 2; ++bj) { const int cl = cl0 + bj * 128; const f32x4 v0 = acc[ai][bj][m][0], v1 = acc[ai][bj][m][1];
                    if (u.pn < 2) { float* p = ZQ + row * 512 + u.pn * 256 + cl; *(f32x4*)p = v0; *(f32x4*)(p + 4) = v1; }
                    else if (u.pn == 2) { float* p = ZC + row * 256 + cl; *(f32x4*)p = v0; *(f32x4*)(p + 4) = v1; }
                    else if (u.pn < 7) *(u32x4*)(UB + row * 1024 + (u.pn - 3) * 256 + cl) = pack8(v0, v1);
                    else if (u.pn < 11) *(u32x4*)(VPRE + row * 1024 + (u.pn - 7) * 256 + cl) = pack8(v0, v1);
                    else if (cl < 32) { float* p = ZK + row * 32 + cl; *(f32x4*)p = v0; *(f32x4*)(p + 4) = v1; } } }
    }
};
struct EpiQ { static constexpr bool PERM = true; bf16_t* QP; bf16_t* QS; const float* rope;
    __device__ __forceinline__ void operator()(AccRef acc, const Unit& u, int wr, int wc, int fr, int fq) const {
        const int row0 = u.pm * 256 + wr * 64 + fr;
#pragma unroll
        for (int ai = 0; ai < 2; ++ai)
#pragma unroll
            for (int m = 0; m < 4; ++m) { const int row = row0 + ai * 128 + m * 16;
                if (u.pn < 4) {
#pragma unroll
                    for (int bj = 0; bj < 2; ++bj) { const int col = u.pn * 256 + bj * 128 + wc * 32 + 8 * fq, h = col >> 6, d = col & 63;
                        *(u32x4*)(QP + (size_t)row * 1536 + h * 96 + d) = pack8(acc[ai][bj][m][0] * C2, acc[ai][bj][m][1] * C2); }
                } else {
                    const int pos = row < MP ? (row & (SEQ - 1)) : 4096 + ((row - MP) & 63);
                    const f32x4 cs = *(const f32x4*)(rope + (size_t)pos * 32 + 4 * fq), sn = *(const f32x4*)(rope + (size_t)pos * 32 + 16 + 4 * fq);
#pragma unroll
                    for (int bj = 0; bj < 2; ++bj) { const int h = (u.pn - 4) * 8 + bj * 4 + wc; const f32x4 x1 = acc[ai][bj][m][0], x2 = acc[ai][bj][m][1];
                        const f32x4 o1 = (x1 * cs - x2 * sn) * C2, o2 = (x2 * cs + x1 * sn) * C2;
                        bf16_t* p = row < MP ? QP + (size_t)row * 1536 + h * 96 + 64 + 4 * fq : QS + (size_t)(row - MP) * 4608 + h * 288 + 256 + 4 * fq;
                        u32x2 w1, w2; w1.x = pk2(o1[0], o1[1]); w1.y = pk2(o1[2], o1[3]); w2.x = pk2(o2[0], o2[1]); w2.y = pk2(o2[2], o2[3]);
                        *(u32x2*)p = w1; *(u32x2*)(p + 16) = w2; }
                } }
    }
};
struct EpiQlat { static constexpr bool PERM = true; bf16_t* QS;
    __device__ __forceinline__ void operator()(AccRef acc, const Unit& u, int wr, int wc, int fr, int fq) const {
        const int row0 = u.lm * 256 + wr * 64 + fr;
#pragma unroll
        for (int ai = 0; ai < 2; ++ai)
#pragma unroll
            for (int m = 0; m < 4; ++m)
#pragma unroll
                for (int bj = 0; bj < 2; ++bj) { const int col = u.pn * 256 + bj * 128 + wc * 32 + 8 * fq, h = col >> 8, r = col & 255;
                    *(u32x4*)(QS + (size_t)(row0 + ai * 128 + m * 16) * 4608 + h * 288 + r) = pack8(acc[ai][bj][m][0] * C2, acc[ai][bj][m][1] * C2); }
    }
};
struct EpiKV { static constexpr bool PERM = true; bf16_t* KP; bf16_t* VP;
    __device__ __forceinline__ void operator()(AccRef acc, const Unit& u, int wr, int wc, int fr, int fq) const {
        const int row0 = u.pm * 256 + wr * 64 + fr;
#pragma unroll
        for (int ai = 0; ai < 2; ++ai)
#pragma unroll
            for (int m = 0; m < 4; ++m) { const size_t row = (size_t)(row0 + ai * 128 + m * 16);
#pragma unroll
                for (int bj = 0; bj < 2; ++bj) { const int col = u.pn * 256 + bj * 128 + wc * 32 + 8 * fq; const u32x4 w = pack8(acc[ai][bj][m][0], acc[ai][bj][m][1]);
                    if (u.pn < 4) *(u32x4*)(KP + row * 1024 + col) = w;        else *(u32x4*)(VP + row * 1024 + (col - 1024)) = w; } }
    }
};
struct EpiPlain { static constexpr bool PERM = true; bf16_t* O; int ldc;
    __device__ __forceinline__ void operator()(AccRef acc, const Unit& u, int wr, int wc, int fr, int fq) const {
        const int row0 = u.pm * 256 + wr * 64 + fr;
#pragma unroll
        for (int ai = 0; ai < 2; ++ai)
#pragma unroll
            for (int m = 0; m < 4; ++m)
#pragma unroll
                for (int bj = 0; bj < 2; ++bj) { const int col = u.pn * 256 + bj * 128 + wc * 32 + 8 * fq;
                    *(u32x4*)(O + (size_t)(row0 + ai * 128 + m * 16) * ldc + col) = pack8(acc[ai][bj][m][0], acc[ai][bj][m][1]); }
    }
};
}

namespace att {
constexpr float THR = 8.f;
__device__ __forceinline__ int crow(int r, int hi) { return (r & 3) + 8 * (r >> 2) + 4 * hi; }
__device__ __forceinline__ unsigned cvtpk(float lo, float hi) { unsigned r; asm volatile("v_cvt_pk_bf16_f32 %0, %1, %2" : "=v"(r) : "v"(lo), "v"(hi)); return r; }
template <int NVB> __device__ __forceinline__ int v_st(int k, int c) { const int kk = k;        return ((kk >> 3) * NVB + (c >> 5)) * 512 + ((kk & 7) * 32 + (c & 31)) * 2; }
__device__ __forceinline__ int v_rd_base(int lane) { return ((lane & 3) << 3) | (((lane >> 2) & 3) << 6) | (((lane >> 4) & 1) << 5) | (((lane >> 5) & 1) << 8); }
template <int OFF> __device__ __forceinline__ s16x4 tr_read(int vb) { s16x4 r; asm volatile("ds_read_b64_tr_b16 %0, %1 offset:%2" : "=&v"(r) : "v"(vb), "i"(OFF) : "memory"); return r; }
struct VFrag { s16x4 l0, h0, l1, h1, l2, h2, l3, h3; };
template <int NVB, int D0> __device__ __forceinline__ void pv_load(VFrag& f, int vb) {
    constexpr int KS = 2 * NVB * 512, HF = NVB * 512;
    f.l0 = tr_read<D0 * 512 + 0 * KS>(vb); f.h0 = tr_read<D0 * 512 + 0 * KS + HF>(vb); f.l1 = tr_read<D0 * 512 + 1 * KS>(vb); f.h1 = tr_read<D0 * 512 + 1 * KS + HF>(vb);
    f.l2 = tr_read<D0 * 512 + 2 * KS>(vb); f.h2 = tr_read<D0 * 512 + 2 * KS + HF>(vb); f.l3 = tr_read<D0 * 512 + 3 * KS>(vb); f.h3 = tr_read<D0 * 512 + 3 * KS + HF>(vb);
}
template <int PENDING> __device__ __forceinline__ void pv_mma(f32x16& od, const VFrag& f, bf16x8 pa0, bf16x8 pa1, bf16x8 pa2, bf16x8 pa3) {
    if constexpr (PENDING == 8) asm volatile("s_waitcnt lgkmcnt(8)" ::: "memory"); else asm volatile("s_waitcnt lgkmcnt(0)" ::: "memory"); __builtin_amdgcn_sched_barrier(0);
#define PK(L, H) (bf16x8){L[0], L[1], L[2], L[3], H[0], H[1], H[2], H[3]}
    od = __builtin_amdgcn_mfma_f32_32x32x16_bf16(PK(f.l0, f.h0), pa0, od, 0, 0, 0);
    od = __builtin_amdgcn_mfma_f32_32x32x16_bf16(PK(f.l1, f.h1), pa1, od, 0, 0, 0);
    od = __builtin_amdgcn_mfma_f32_32x32x16_bf16(PK(f.l2, f.h2), pa2, od, 0, 0, 0);
    od = __builtin_amdgcn_mfma_f32_32x32x16_bf16(PK(f.l3, f.h3), pa3, od, 0, 0, 0);
#undef PK
}
template <int NVB, int D0> __device__ __forceinline__ void pv_one(f32x16& od, int vb, bf16x8 pa0, bf16x8 pa1, bf16x8 pa2, bf16x8 pa3) { VFrag f; pv_load<NVB, D0>(f, vb); pv_mma<0>(od, f, pa0, pa1, pa2, pa3); }
#define PK4(P, BASE, OUT) do { u32x4 w = {cvtpk(P[BASE + 0], P[BASE + 1]), cvtpk(P[BASE + 2], P[BASE + 3]), cvtpk(P[BASE + 4], P[BASE + 5]), cvtpk(P[BASE + 6], P[BASE + 7])}; OUT = __builtin_bit_cast(bf16x8, w); } while (0)
__device__ __forceinline__ bool softmax_tile(f32x16& p0, f32x16& p1, float& m_reg, float& l_reg, float& alpha, bf16x8& pa0, bf16x8& pa1, bf16x8& pa2, bf16x8& pa3) {
    float pmax = p0[0];
#pragma unroll
    for (int r = 1; r < 16; ++r) pmax = fmaxf(pmax, p0[r]);
#pragma unroll
    for (int r = 0; r < 16; ++r) pmax = fmaxf(pmax, p1[r]);
    { float lo_, hi_; half_swap(pmax, lo_, hi_); pmax = fmaxf(lo_, hi_); }
    float mn;
    if (__all(pmax - m_reg <= THR)) { mn = m_reg; alpha = 1.f; }
    else { mn = fmaxf(m_reg, pmax); alpha = ex2(m_reg - mn); m_reg = mn; }
    float ps = 0.f;
#pragma unroll
    for (int r = 0; r < 16; ++r) { p0[r] = ex2(p0[r] - mn); ps += p0[r]; }
#pragma unroll
    for (int r = 0; r < 16; ++r) { p1[r] = ex2(p1[r] - mn); ps += p1[r]; }
    { float lo_, hi_; half_swap(ps, lo_, hi_); ps = lo_ + hi_; }
    l_reg = l_reg * alpha + ps;
    PK4(p0, 0, pa0); PK4(p0, 8, pa1); PK4(p1, 0, pa2); PK4(p1, 8, pa3);
    return __any(alpha < 1.f);
}
__device__ __forceinline__ bool softmax_tile_rel(f32x16& p0, f32x16& p1, float& m_reg, float& l_reg, float& alpha, f32x16& negm, bool first, bf16x8& pa0, bf16x8& pa1, bf16x8& pa2, bf16x8& pa3) {
    f32x16 e0, e1; float ps = 0.f;
#pragma unroll
    for (int r = 0; r < 16; ++r) { e0[r] = ex2(p0[r]); ps += e0[r]; }
#pragma unroll
    for (int r = 0; r < 16; ++r) { e1[r] = ex2(p1[r]); ps += e1[r]; }
    const bool upd = first || !__all(ps <= 256.f);
    alpha = 1.f;
    if (upd) {
        float pmax = p0[0];
#pragma unroll
        for (int r = 1; r < 16; ++r) pmax = fmaxf(pmax, p0[r]);
#pragma unroll
        for (int r = 0; r < 16; ++r) pmax = fmaxf(pmax, p1[r]);
        float lo_, hi_; half_swap(pmax, lo_, hi_); pmax = fmaxf(lo_, hi_); const float d = first ? pmax : fmaxf(pmax, 0.f); alpha = first ? 1.f : ex2(-d); m_reg += d;
        ps = 0.f;
#pragma unroll
        for (int r = 0; r < 16; ++r) { e0[r] = ex2(p0[r] - d); ps += e0[r]; }
#pragma unroll
        for (int r = 0; r < 16; ++r) { e1[r] = ex2(p1[r] - d); ps += e1[r]; }
#pragma unroll
        for (int r = 0; r < 16; ++r) negm[r] = -m_reg; }
    l_reg = l_reg * alpha + ps;
    PK4(e0, 0, pa0); PK4(e0, 8, pa1); PK4(e1, 0, pa2); PK4(e1, 8, pa3);
    return upd && !first;
}
#undef PK4

template <bool SAMPLE>
__device__ __forceinline__ void attn_unit(char* lds, const bf16_t* __restrict__ Qrow  , const bf16_t* __restrict__ Kg, const bf16_t* __restrict__ Vg, int NT, int jmax,
                                          bf16_t* __restrict__ Orow0  , int ldo, int vcol0  ) {
    constexpr int NKS = SAMPLE ? 18 : 6, NCB = SAMPLE ? 4 : 2, NVB = SAMPLE ? 8 : 2, KROWB = SAMPLE ? 592 : 208, KBYTES = 64 * KROWB, VBYTES = 64 * NVB * 64, BUF = KBYTES + VBYTES;
    constexpr int LDK = SAMPLE ? 288 : 1536, LDV = SAMPLE ? 288 : 1024, KCH = SAMPLE ? 36 : 12, NKC = 64 * KCH, NSTG = SAMPLE ? 5 : 2;
    int tid_ = threadIdx.x; asm volatile("" : "+v"(tid_));
    const int tid = tid_, wid = tid >> 6, lane = tid & 63, r32 = lane & 31, hi = lane >> 5;
    float* wsf = (float*)(lds + 2 * BUF) + wid * 64; float* li_l = wsf; float* al_l = wsf + 32;
    bf16x8 qr[NKS];
#pragma unroll
    for (int d0 = 0; d0 < NKS; ++d0) qr[d0] = *(const bf16x8*)(Qrow + d0 * 16);
    int srow[NSTG], sch[NSTG];
#pragma unroll
    for (int k = 0; k < NSTG; ++k) { const int idx = tid + 512 * k; srow[k] = idx / KCH; sch[k] = idx % KCH; }
    bf16x8 sk[NSTG]; bf16x8 sv;
#define SLOAD(t) do { _Pragma("unroll") for (int k = 0; k < NSTG; ++k) if (tid + 512 * k < NKC) sk[k] = *(const bf16x8*)(Kg + (size_t)((t) * 64 + srow[k]) * LDK + sch[k] * 8); \
        if (!SAMPLE) sv = *(const bf16x8*)(Vg + (size_t)((t) * 64 + (tid >> 3)) * LDV + (tid & 7) * 8); } while (0)
#define SWRITE(b) do { char* kb_ = lds + (b) * BUF; _Pragma("unroll") for (int k = 0; k < NSTG; ++k) if (tid + 512 * k < NKC) { *(bf16x8*)(kb_ + srow[k] * KROWB + sch[k] * 16) = sk[k]; \
            if (SAMPLE && sch[k] < 32) *(bf16x8*)(kb_ + KBYTES + v_st<NVB>(srow[k], sch[k] * 8)) = sk[k]; } \
        if (!SAMPLE) *(bf16x8*)(kb_ + KBYTES + v_st<NVB>(tid >> 3, (tid & 7) * 8)) = sv; } while (0)
    float m_reg = SAMPLE ? -1e30f : 0.f, l_reg = 0.f; f32x16 o[NCB]; f32x16 negm = f32x16{};
#pragma unroll
    for (int d = 0; d < NCB; ++d) o[d] = f32x16{};
    const int vb0 = (int)(unsigned)(uintptr_t)lds + KBYTES + v_rd_base(lane) + vcol0 * 512;
    SLOAD(0); SWRITE(0); if (NT > 1) SLOAD(1);
    __syncthreads();
    for (int j = 0; j < NT; ++j) {
        const int b = j & 1;
        if (j <= jmax) {
            const char* Ks = lds + b * BUF;
            f32x16 p0 = f32x16{}, p1 = f32x16{};
#pragma unroll
            for (int d0 = 0; d0 < NKS; ++d0) { const int cb = (d0 * 16 + hi * 8) * 2;
                const bf16x8 k0 = *(const bf16x8*)(Ks + r32 * KROWB + cb), k1 = *(const bf16x8*)(Ks + (32 + r32) * KROWB + cb);
                if (!SAMPLE && d0 == 0) { p0 = __builtin_amdgcn_mfma_f32_32x32x16_bf16(k0, qr[0], negm, 0, 0, 0); p1 = __builtin_amdgcn_mfma_f32_32x32x16_bf16(k1, qr[0], negm, 0, 0, 0); }
                else { p0 = __builtin_amdgcn_mfma_f32_32x32x16_bf16(k0, qr[d0], p0, 0, 0, 0); p1 = __builtin_amdgcn_mfma_f32_32x32x16_bf16(k1, qr[d0], p1, 0, 0, 0); } }
            float alpha; bf16x8 pa0, pa1, pa2, pa3;
            bool resc;
            if constexpr (SAMPLE) resc = softmax_tile(p0, p1, m_reg, l_reg, alpha, pa0, pa1, pa2, pa3);
            else resc = softmax_tile_rel(p0, p1, m_reg, l_reg, alpha, negm, j == 0, pa0, pa1, pa2, pa3);
            if (resc) {
#pragma unroll
                for (int d = 0; d < NCB; ++d)
#pragma unroll
                    for (int r = 0; r < 16; ++r) o[d][r] *= alpha; }
            const int vb = vb0 + b * BUF;
            pv_one<NVB, 0>(o[0], vb, pa0, pa1, pa2, pa3); pv_one<NVB, 1>(o[1], vb, pa0, pa1, pa2, pa3);
            if constexpr (NCB == 4) { pv_one<NVB, 2>(o[2], vb, pa0, pa1, pa2, pa3); pv_one<NVB, 3>(o[3], vb, pa0, pa1, pa2, pa3); }
        }
        if (j + 1 < NT) SWRITE(b ^ 1);
        if (j + 2 < NT) SLOAD(j + 2);
        __syncthreads();
    }
    if constexpr (!SAMPLE) { float lo_, hi_; half_swap(l_reg, lo_, hi_); l_reg = lo_ + hi_; }
    { const float rl = __builtin_amdgcn_rcpf(l_reg); bf16_t* orow = Orow0 + (size_t)r32 * ldo + 4 * hi;
#pragma unroll
      for (int d0 = 0; d0 < NCB; ++d0)
#pragma unroll
          for (int i = 0; i < 4; ++i) { u32x2 w; w.x = pk2(o[d0][4 * i] * rl, o[d0][4 * i + 1] * rl); w.y = pk2(o[d0][4 * i + 2] * rl, o[d0][4 * i + 3] * rl); *(u32x2*)(orow + d0 * 32 + 8 * i) = w; } }
    __syncthreads();
#undef SLOAD
#undef SWRITE
}

__device__ __forceinline__ void attn_unit_p2(char* lds, const bf16_t* __restrict__ Qrow, const bf16_t* __restrict__ Kg, const bf16_t* __restrict__ Kpe  , const bf16_t* __restrict__ Vg, int NT, int jmax, bf16_t* __restrict__ Orow0, int ldo) {
    constexpr int NKS = 6, NVB = 2, KROWB = 208, KBYTES = 64 * KROWB, VBYTES = 64 * NVB * 64, TB = KBYTES + VBYTES, BUF = 3 * TB, LDK = 1024, LDV = 1024, KCH = 12, NKC = 64 * KCH;
    int tid_ = threadIdx.x; asm volatile("" : "+v"(tid_));
    const int tid = tid_, lane = tid & 63, r32 = lane & 31, hi = lane >> 5;
    bf16x8 qr[NKS];
#pragma unroll
    for (int d0 = 0; d0 < NKS; ++d0) qr[d0] = *(const bf16x8*)(Qrow + d0 * 16);
    const int sr0 = tid / KCH, sc0 = tid % KCH, sr1 = (tid + 512) / KCH, sc1 = (tid + 512) % KCH; const bool two = tid + 512 < NKC;
    const bf16_t* kp0 = sc0 < 8 ? Kg + (size_t)sr0 * LDK + sc0 * 8 : Kpe + (size_t)sr0 * 32 + (sc0 - 8) * 8; const int ks0 = sc0 < 8 ? 64 * LDK : 64 * 32;
    const bf16_t* kp1 = sc1 < 8 ? Kg + (size_t)sr1 * LDK + sc1 * 8 : Kpe + (size_t)sr1 * 32 + (sc1 - 8) * 8; const int ks1 = sc1 < 8 ? 64 * LDK : 64 * 32;
    bf16x8 ka0, ka1 = bf16x8{}, va, kb0, kb1 = bf16x8{}, vb_, kc0, kc1 = bf16x8{}, vc;
#define SLOAD1(t, K0, K1, V_) do { const int t_ = (t) < NT ? (t) : NT - 1; K0 = *(const bf16x8*)(kp0 + (size_t)t_ * ks0); if (two) K1 = *(const bf16x8*)(kp1 + (size_t)t_ * ks1); \
        V_ = *(const bf16x8*)(Vg + (size_t)(t_ * 64 + (tid >> 3)) * LDV + (tid & 7) * 8); } while (0)
#define SWRITE1(base_, K0, K1, V_) do { char* kb_ = (base_); *(bf16x8*)(kb_ + sr0 * KROWB + sc0 * 16) = K0; if (two) *(bf16x8*)(kb_ + sr1 * KROWB + sc1 * 16) = K1; \
        *(bf16x8*)(kb_ + KBYTES + v_st<NVB>(tid >> 3, (tid & 7) * 8)) = V_; } while (0)
#define SLOAD3(pr) do { SLOAD1(3 * (pr), ka0, ka1, va); SLOAD1(3 * (pr) + 1, kb0, kb1, vb_); SLOAD1(3 * (pr) + 2, kc0, kc1, vc); } while (0)
#define SWRITE3(st_) do { SWRITE1(lds + (st_) * BUF, ka0, ka1, va); SWRITE1(lds + (st_) * BUF + TB, kb0, kb1, vb_); SWRITE1(lds + (st_) * BUF + 2 * TB, kc0, kc1, vc); } while (0)
    float m_reg = 0.f, l_reg = 0.f; f32x16 o0 = f32x16{}, o1 = f32x16{}, negm = f32x16{};
    const int vrd = (int)(unsigned)(uintptr_t)lds + KBYTES + v_rd_base(lane);
#define KPRE(off_, A_, B_) do { const char* Ks_ = lds + (off_) + hi * 16; A_ = *(const bf16x8*)(Ks_ + r32 * KROWB); B_ = *(const bf16x8*)(Ks_ + (32 + r32) * KROWB); } while (0)
#define TILE_QS(off_, first_, A_, B_) do { const char* Ks = lds + (off_); f32x16 p0, p1; \
        p0 = __builtin_amdgcn_mfma_f32_32x32x16_bf16(A_, qr[0], negm, 0, 0, 0); p1 = __builtin_amdgcn_mfma_f32_32x32x16_bf16(B_, qr[0], negm, 0, 0, 0); \
        _Pragma("unroll") for (int d0 = 1; d0 < NKS; ++d0) { const int cb = (d0 * 16 + hi * 8) * 2; \
            const bf16x8 k0 = *(const bf16x8*)(Ks + r32 * KROWB + cb), k1 = *(const bf16x8*)(Ks + (32 + r32) * KROWB + cb); \
            p0 = __builtin_amdgcn_mfma_f32_32x32x16_bf16(k0, qr[d0], p0, 0, 0, 0); p1 = __builtin_amdgcn_mfma_f32_32x32x16_bf16(k1, qr[d0], p1, 0, 0, 0); } \
        pv_load<NVB, 0>(vf0, vrd + (off_)); \
        float alpha; const bool resc = softmax_tile_rel(p0, p1, m_reg, l_reg, alpha, negm, (first_), pa0, pa1, pa2, pa3); \
        if (resc) { _Pragma("unroll") for (int r = 0; r < 16; ++r) { o0[r] *= alpha; o1[r] *= alpha; } } } while (0)
#define TILE_PV(off_) do { VFrag vf1; pv_load<NVB, 1>(vf1, vrd + (off_)); pv_mma<8>(o0, vf0, pa0, pa1, pa2, pa3); pv_mma<0>(o1, vf1, pa0, pa1, pa2, pa3); } while (0)
    const int NP = (NT + 2) / 3;
    SLOAD3(0); SWRITE3(0); if (NP > 1) SLOAD3(1);
    __syncthreads();
    for (int jj = 0; jj < NP; ++jj) {
        const int so = (jj & 1) * BUF;
        if (3 * jj <= jmax) { bf16x8 fa, fb, pa0, pa1, pa2, pa3; VFrag vf0;
            KPRE(so, fa, fb); TILE_QS(so, jj == 0, fa, fb);
            if (3 * jj + 1 <= jmax) KPRE(so + TB, fa, fb);
            TILE_PV(so);
            if (3 * jj + 1 <= jmax) { TILE_QS(so + TB, false, fa, fb);
                if (3 * jj + 2 <= jmax) KPRE(so + 2 * TB, fa, fb);
                TILE_PV(so + TB);
                if (3 * jj + 2 <= jmax) { TILE_QS(so + 2 * TB, false, fa, fb); TILE_PV(so + 2 * TB); } } }
        if (jj + 1 < NP) SWRITE3((jj & 1) ^ 1);
        if (jj + 2 < NP) SLOAD3(jj + 2);
        __syncthreads();
    }
#undef SLOAD1
#undef SWRITE1
#undef SLOAD3
#undef SWRITE3
#undef KPRE
#undef TILE_QS
#undef TILE_PV
    { float lo_, hi_; half_swap(l_reg, lo_, hi_); l_reg = lo_ + hi_; }
    { const float rl = __builtin_amdgcn_rcpf(l_reg); bf16_t* orow = Orow0 + (size_t)r32 * ldo + 4 * hi;
#pragma unroll
      for (int i = 0; i < 4; ++i) { u32x2 w0, w1; w0.x = pk2(o0[4 * i] * rl, o0[4 * i + 1] * rl); w0.y = pk2(o0[4 * i + 2] * rl, o0[4 * i + 3] * rl); w1.x = pk2(o1[4 * i] * rl, o1[4 * i + 1] * rl); w1.y = pk2(o1[4 * i + 2] * rl, o1[4 * i + 3] * rl);
          *(u32x2*)(orow + 8 * i) = w0; *(u32x2*)(orow + 32 + 8 * i) = w1; } }
    __syncthreads();
}
}

#define XB_TMO      128
#define XB_XCNT(j)  (256  + 64 * (j))
#define XB_XSUB(j)  (1280 + 64 * (j))
#define XB_XGEN(j)  (2304 + 64 * (j))
#define XB_TOP      3328
#define XB_TOPGEN   3392
#define XCD_BAR_WORDS 3456
#define XB_SPIN_CAP (1u << 22)
__device__ __forceinline__ unsigned xb_ld(unsigned* p)              { return __hip_atomic_load(p, __ATOMIC_RELAXED, __HIP_MEMORY_SCOPE_AGENT); }
__device__ __forceinline__ unsigned xb_add(unsigned* p, unsigned v) { return __hip_atomic_fetch_add(p, v, __ATOMIC_RELAXED, __HIP_MEMORY_SCOPE_AGENT); }
__device__ __forceinline__ unsigned xb_xcc_id() { return (unsigned)__builtin_amdgcn_s_getreg((3 << 11) | 20) & 0xFu; }
#define XB_SPIN(cond, bar) do { unsigned _sp = 0; while (cond) { __builtin_amdgcn_s_sleep(1); \
    if ((++_sp & 255u) == 0u) { if (xb_ld(&(bar)[XB_TMO])) break; if (_sp > XB_SPIN_CAP) { atomicAdd(&(bar)[XB_TMO], 1u); break; } } } } while (0)
struct XcdBarrier { unsigned* bar; unsigned x; volatile LAS unsigned* st; };
__device__ __forceinline__ XcdBarrier xcd_barrier_post(unsigned* bar, volatile LAS unsigned* st) {
    XcdBarrier b; b.bar = bar; b.x = xb_xcc_id(); b.st = st;
    if (threadIdx.x == 0) (void)xb_add(&bar[XB_XCNT(b.x)], 1u);
    return b;
}
__device__ __forceinline__ void xcd_barrier_complete(unsigned* bar, unsigned x, unsigned& nloc, unsigned& nx) {
    const unsigned G = gridDim.x * gridDim.y * gridDim.z;
    unsigned sum, cnt, mine, sp = 0u;
    for (;;) {
        sum = 0u; cnt = 0u; mine = 0u;
#pragma unroll
        for (unsigned j = 0; j < 16; ++j) { const unsigned c = xb_ld(&bar[XB_XCNT(j)]); sum += c; cnt += (c > 0u) ? 1u : 0u; mine = (j == x) ? c : mine; }
        if (sum == G) break;
        __builtin_amdgcn_s_sleep(1);
        if ((++sp & 255u) == 0u) { if (xb_ld(&bar[XB_TMO])) break; if (sp > XB_SPIN_CAP) { atomicAdd(&bar[XB_TMO], 1u); break; } }
    }
    nloc = mine > 0u ? mine : 1u; nx = cnt > 0u ? cnt : 1u;
}
__device__ __forceinline__ void xcd_barrier(const XcdBarrier& b) {
    asm volatile("s_waitcnt vmcnt(0)" ::: "memory");
    __syncthreads();
    if (threadIdx.x == 0) {
        unsigned* bar = b.bar;
        __builtin_amdgcn_s_waitcnt(0);
        unsigned nloc = b.st[0], nx = b.st[1];
        if (nloc == 0u) { xcd_barrier_complete(bar, b.x, nloc, nx); b.st[0] = nloc; b.st[1] = nx; }
        const unsigned old = xb_add(&bar[XB_XSUB(b.x)], 1u);
        const unsigned gen = old / nloc;
        if (old + 1u == (gen + 1u) * nloc) {
            __builtin_amdgcn_fence(__ATOMIC_RELEASE, "agent");
            asm volatile("s_waitcnt vmcnt(0)" ::: "memory");
            const unsigned og = xb_add(&bar[XB_TOP], 1u);
            const unsigned tg = og / nx;
            if (og + 1u == (tg + 1u) * nx) xb_add(&bar[XB_TOPGEN], 1u);
            else XB_SPIN(xb_ld(&bar[XB_TOPGEN]) == tg, bar);
            __builtin_amdgcn_fence(__ATOMIC_ACQUIRE, "agent");
            xb_add(&bar[XB_XGEN(b.x)], 1u);
            asm volatile("s_waitcnt vmcnt(0)" ::: "memory");
        } else {
            XB_SPIN(xb_ld(&bar[XB_XGEN(b.x)]) == gen, bar);
            __builtin_amdgcn_fence(__ATOMIC_ACQUIRE, "agent");
            asm volatile("s_waitcnt vmcnt(0)" ::: "memory");
        }
    }
    __syncthreads();
}


__device__ __forceinline__ void ln_load(const bf16_t* T, const bf16_t* XBo, const bf16_t* PARTp, float pscale, int row, int lane, float (&v)[32]) {
    if (row >= MP) {
#pragma unroll
        for (int j = 0; j < 4; ++j) { const int c = 512 * j + 8 * lane; const u32x4 xw = *(const u32x4*)(XBo + (size_t)row * DM + c); const bf16_t* pp = PARTp + (size_t)(row - MP) * DM + c;
            const u32x4 s0 = *(const u32x4*)pp, s1 = *(const u32x4*)(pp + (size_t)MS * DM), s2 = *(const u32x4*)(pp + (size_t)2 * MS * DM), s3 = *(const u32x4*)(pp + (size_t)3 * MS * DM);
            const unsigned xv[4] = {xw.x, xw.y, xw.z, xw.w}, a0[4] = {s0.x, s0.y, s0.z, s0.w}, a1[4] = {s1.x, s1.y, s1.z, s1.w}, a2[4] = {s2.x, s2.y, s2.z, s2.w}, a3[4] = {s3.x, s3.y, s3.z, s3.w};
#pragma unroll
            for (int e = 0; e < 4; ++e) { v[8 * j + 2 * e] = bflo(xv[e]) * ALPHA + ((bflo(a0[e]) + bflo(a1[e])) + (bflo(a2[e]) + bflo(a3[e]))) * pscale;
                v[8 * j + 2 * e + 1] = bfhi(xv[e]) * ALPHA + ((bfhi(a0[e]) + bfhi(a1[e])) + (bfhi(a2[e]) + bfhi(a3[e]))) * pscale; } }
    } else {
#pragma unroll
        for (int j = 0; j < 4; ++j) { const u32x4 tw = *(const u32x4*)(T + (size_t)row * DM + 512 * j + 8 * lane);
            v[8 * j + 0] = bflo(tw.x); v[8 * j + 1] = bfhi(tw.x); v[8 * j + 2] = bflo(tw.y); v[8 * j + 3] = bfhi(tw.y); v[8 * j + 4] = bflo(tw.z); v[8 * j + 5] = bfhi(tw.z); v[8 * j + 6] = bflo(tw.w); v[8 * j + 7] = bfhi(tw.w); }
    }
}
__device__ __forceinline__ void ln_store(bf16_t* XBo, float* Y, const float (&g)[32], const float (&bb)[32], int row, int lane, float (&v)[32], float mu, float r) {
#pragma unroll
    for (int j = 0; j < 4; ++j) { const int c = 512 * j + 8 * lane;
        const f32x4 o0 = ((f32x4){v[8 * j], v[8 * j + 1], v[8 * j + 2], v[8 * j + 3]} - mu) * r * (f32x4){g[8 * j], g[8 * j + 1], g[8 * j + 2], g[8 * j + 3]} + (f32x4){bb[8 * j], bb[8 * j + 1], bb[8 * j + 2], bb[8 * j + 3]};
        const f32x4 o1 = ((f32x4){v[8 * j + 4], v[8 * j + 5], v[8 * j + 6], v[8 * j + 7]} - mu) * r * (f32x4){g[8 * j + 4], g[8 * j + 5], g[8 * j + 6], g[8 * j + 7]} + (f32x4){bb[8 * j + 4], bb[8 * j + 5], bb[8 * j + 6], bb[8 * j + 7]};
        if (Y) { *(f32x4*)(Y + (size_t)row * DM + c) = o0; *(f32x4*)(Y + (size_t)row * DM + c + 4) = o1; }
        else *(u32x4*)(XBo + (size_t)row * DM + c) = pack8(o0, o1); }
}
__device__ __forceinline__ void ln_pass(const bf16_t* T, bf16_t* XBo, float* Y, const bf16_t* PARTp, float pscale, const float* lg, const float* lb, int gw, int NGW, int lane) {
    float g[32], bb[32];
#pragma unroll
    for (int j = 0; j < 4; ++j) { const int c = 512 * j + 8 * lane; const f32x4 g0 = *(const f32x4*)(lg + c), g1 = *(const f32x4*)(lg + c + 4), b0 = *(const f32x4*)(lb + c), b1 = *(const f32x4*)(lb + c + 4);
#pragma unroll
        for (int e = 0; e < 4; ++e) { g[8 * j + e] = g0[e]; g[8 * j + 4 + e] = g1[e]; bb[8 * j + e] = b0[e]; bb[8 * j + 4 + e] = b1[e]; } }
    const int nk = (MT - gw + NGW - 1) / NGW;
    for (int q = 0; q < nk; q += 2) {
        const int kA = q == 0 ? nk - 1 : q - 1, kB = q; const bool hasB = q + 1 < nk; const int row = gw + kA * NGW, rowB = gw + kB * NGW; const int rB = hasB ? rowB : row;
        float va[32], vb[32];
        ln_load(T, XBo, PARTp, pscale, row, lane, va); ln_load(T, XBo, PARTp, pscale, rB, lane, vb);
        float sa = 0.f, sb = 0.f;
#pragma unroll
        for (int e = 0; e < 32; ++e) { sa += va[e]; sb += vb[e]; }
        const float mua = wave_sum(sa) * (1.f / DM), mub = wave_sum(sb) * (1.f / DM); float qa = 0.f, qb = 0.f;
#pragma unroll
        for (int e = 0; e < 32; ++e) { const float da = va[e] - mua, db = vb[e] - mub; qa += da * da; qb += db * db; }
        const float ra = 1.f / sqrtf(wave_sum(qa) * (1.f / DM) + LN_EPS), rb_ = 1.f / sqrtf(wave_sum(qb) * (1.f / DM) + LN_EPS);
        ln_store(XBo, Y, g, bb, row, lane, va, mua, ra);
        if (hasB) ln_store(XBo, Y, g, bb, rowB, lane, vb, mub, rb_);
    }
}

__device__ __forceinline__ void transpose_item(const GAS float* W, int K, int N, GAS bf16_t* WT, int ldt, int coff, int map, int p0, int item, int lane) {
    const int nblk = (N + 63) >> 6, kc = item / nblk, nb = item - kc * nblk, n = nb * 64 + lane, k0 = kc * 256, k1 = (k0 + 256 < K) ? k0 + 256 : K;
    if (n < N) {
        int drow;
        if (map == 0) drow = n + p0;
        else if (map == 1) drow = (n >> 7) * 256 + (n & 127) + p0;
        else if (map == 2) drow = n < 768 ? n : (n < 800 ? 2816 + (n - 768) : n - 32);
        else { const int h = n / 96, e = n - h * 96; if (e < 64) drow = h * 64 + e; else { const int i2 = e - 64; drow = 1024 + h * 32 + 8 * ((i2 & 15) >> 2) + 4 * (i2 >> 4) + (i2 & 3); } }
        const GAS float* src = W + (size_t)k0 * N + n; GAS bf16_t* dst = WT + (size_t)drow * ldt + coff + k0;
#pragma unroll 4
        for (int k = k0; k < k1; k += 8) { float v[8];
#pragma unroll
            for (int j = 0; j < 8; ++j) v[j] = src[(size_t)j * N];
            u32x4 o; o.x = pk2(v[0], v[1]); o.y = pk2(v[2], v[3]); o.z = pk2(v[4], v[5]); o.w = pk2(v[6], v[7]);
            *(GAS u32x4*)dst = o; src += (size_t)8 * N; dst += 8; }
    }
}
struct Args { const float* in[40]; float* out; unsigned char* ws; };

struct SsmLam { double lr, li, dt; };
__device__ __forceinline__ SsmLam ssm_lam(const float* lam_re, const float* lam_im, const float* log_dt, int g, int p) { SsmLam s; s.lr = lam_re[g * 64 + p]; s.li = lam_im[g * 64 + p]; s.dt = dexp((double)log_dt[g]); return s; }
__device__ __forceinline__ void ssm_pow(const SsmLam& s, int k, double& wr, double& wi) { const double mag = dexp(s.lr * s.dt * k); double sn, cs; dsincos(s.li * s.dt * k, sn, cs); wr = mag * cs; wi = mag * sn; }
__device__ __forceinline__ void ssm_co(const SsmLam& s, double& cr, double& ci) { double ar, ai; ssm_pow(s, 1, ar, ai); const double den = s.lr * s.lr + s.li * s.li, nr = ar - 1.0; cr = (nr * s.lr + ai * s.li) / den; ci = (ai * s.lr - nr * s.li) / den; }

#define WUP ((bf16_t*)(ws + WS_WUP))
#define WDN ((bf16_t*)(ws + WS_WDN))
#define WINE ((bf16_t*)(ws + WS_WINE))
#define WOUTE ((bf16_t*)(ws + WS_WOUTE))
#define WINO ((bf16_t*)(ws + WS_WINO))
#define WOUTO ((bf16_t*)(ws + WS_WOUTO))
#define WMIXS ((bf16_t*)(ws + WS_WMIXS))
#define AEXPK ((bf16_t*)(ws + WS_AEXPK))
#define AEXPV ((bf16_t*)(ws + WS_AEXPV))
#define WQLAT ((bf16_t*)(ws + WS_WQLAT))
#define WPOOL ((bf16_t*)(ws + WS_WPOOL))
#define WUQ ((bf16_t*)(ws + WS_WUQ))
#define WKV ((bf16_t*)(ws + WS_WKV))
#define WUQN ((bf16_t*)(ws + WS_WUQN))
#define WGLU ((bf16_t*)(ws + WS_WGLU))
#define WSG ((bf16_t*)(ws + WS_WSG))
#define BT1 ((bf16_t*)(ws + WS_BT1))
#define BT2 ((bf16_t*)(ws + WS_BT2))
#define ROPE ((float*)(ws + WS_ROPE))
#define KTAB ((float*)(ws + WS_KTAB))
#define A64 ((float*)(ws + WS_A64))
#define XB ((bf16_t*)(ws + WS_XB))
#define HB ((bf16_t*)(ws + WS_H))
#define ZP ((bf16_t*)(ws + WS_ZP))
#define DP ((bf16_t*)(ws + WS_DP))
#define UP ((bf16_t*)(ws + WS_UP))
#define S1 ((float*)(ws + WS_S1))
#define GACT ((bf16_t*)(ws + WS_GACT))
#define ZQ ((float*)(ws + WS_ZQ))
#define ZC ((float*)(ws + WS_ZC))
#define ZK ((float*)(ws + WS_ZK))
#define UB ((bf16_t*)(ws + WS_UB))
#define VPRE ((bf16_t*)(ws + WS_VPRE))
#define VB ((bf16_t*)(ws + WS_VB))
#define CQN ((bf16_t*)(ws + WS_CQN))
#define CKVB ((bf16_t*)(ws + WS_CKVB))
#define KPEB ((bf16_t*)(ws + WS_KPEB))
#define AS ((bf16_t*)(ws + WS_AS))
#define PART ((bf16_t*)(ws + WS_PART))
#define KP ((bf16_t*)(ws + WS_KP))
#define QP ((bf16_t*)(ws + WS_QP))
#define QS ((bf16_t*)(ws + WS_QS))
#define VP ((bf16_t*)(ws + WS_VP))
#define KXS ((bf16_t*)(ws + WS_KXS))
#define TB ((bf16_t*)out)
#define MIX ((bf16_t*)((unsigned char*)out + 136 * MiB))
#define TFIN ((bf16_t*)(ws + 8 * MiB))
typedef const __attribute__((address_space(4))) Args* ArgsP;
#define PHASE_BEGIN() ArgsP ap = kap; asm volatile("" : "+s"(ap)); unsigned char* const ws = ap->ws; float* const out = ap->out; (void)ws; (void)out; \
    int tid = threadIdx.x; asm volatile("" : "+v"(tid)); int bx = blockIdx.x; asm volatile("" : "+s"(bx)); int G = gridDim.x; asm volatile("" : "+s"(G)); \
    const int lane = tid & 63, wave = __builtin_amdgcn_readfirstlane(tid >> 6), vcu = (G % 8 == 0) ? (bx % 8) * (G / 8) + bx / 8 : bx, gw = bx * NW + wave, NGW = G * NW; \
    const long gt = (long)bx * (NW * 64) + tid, NGT = (long)G * NW * 64; (void)lane; (void)wave; (void)vcu; (void)gw; (void)NGW; (void)gt; (void)NGT
__global__ void __launch_bounds__(NW * 64, 2) fwd_kernel(Args a_unused) {
    extern __shared__ __attribute__((aligned(16))) unsigned char lds_raw[];
    LAS unsigned char* lds = (LAS unsigned char*)lds_raw;
    volatile LAS unsigned* MISC = (volatile LAS unsigned*)(lds + LDSCTL_OFF);
    const ArgsP kap = (ArgsP)__builtin_amdgcn_kernarg_segment_ptr();
    unsigned* ctl = (unsigned*)(kap->ws + WS_CTL);
    if (threadIdx.x < 64) MISC[threadIdx.x] = 0u;
    __syncthreads();
    XcdBarrier bar = xcd_barrier_post(ctl + CW_BAR, MISC + 8);
#define GRID_BAR() do { XcdBarrier b_ = bar; asm volatile("" : "+s"(b_.bar), "+s"(b_.x)); xcd_barrier(b_); } while (0)

    { PHASE_BEGIN();
    {
        LAS unsigned long long* jsrc = (LAS unsigned long long*)(lds + 72 * 1024); LAS unsigned long long* jdst = jsrc + 32;
        LAS int* jK = (LAS int*)(jdst + 32); LAS int* jN = jK + 32; LAS int* jld = jN + 32; LAS int* jco = jld + 32; LAS int* jmap = jco + 32; LAS int* jp0 = jmap + 32; LAS int* jst = jp0 + 32;
        if (tid == 0) {
            int nj = 0, st = 0;
#define ADDJOB(src_, K_, N_, dst_, ld_, co_, map_, p0_) do { jsrc[nj] = (unsigned long long)(uintptr_t)(src_); jdst[nj] = (unsigned long long)(uintptr_t)(dst_); jK[nj] = (K_); jN[nj] = (N_); jld[nj] = (ld_); jco[nj] = (co_); \
                jmap[nj] = (map_); jp0[nj] = (p0_); jst[nj] = st; st += (((K_) + 255) / 256) * (((N_) + 63) / 64); ++nj; } while (0)
            for (int l = 0; l < 1; ++l) for (int f = 0; f < 1; ++f) { const int idx = l * 2 + f;
                ADDJOB(ap->in[9 + 3 * f] + (size_t)l * DM * FF, DM, FF, WUP + (size_t)idx * 11264 * DM, DM, 0, 1, 0);
                ADDJOB(ap->in[10 + 3 * f] + (size_t)l * DM * FF, DM, FF, WUP + (size_t)idx * 11264 * DM, DM, 0, 1, 128);
                ADDJOB(ap->in[11 + 3 * f] + (size_t)l * FF * DM, FF, DM, WDN + (size_t)idx * DM * FF, FF, 0, 0, 0); }
            ADDJOB(ap->in[15], DM, DM, WINE, DM, 0, 0, 0);
            for (int g = 0; g < 4; ++g) ADDJOB(ap->in[16] + (size_t)g * 384 * 384, 384, 384, WPOOL + (size_t)g * 512 * 384, 384, 0, 0, 0);
            ADDJOB(ap->in[26], 512, 512, WGLU, 512, 0, 0, 0);
            ADDJOB(ap->in[28], DM, DM, WOUTE, DM, 0, 0, 0);
            ADDJOB(ap->in[29], DM, 2848, WINO, DM, 0, 2, 0);
            ADDJOB(ap->in[32], 512, 1536, WUQ, 512, 0, 3, 0);
            ADDJOB(ap->in[33], 256, 1024, WKV, 256, 0, 0, 0);
            ADDJOB(ap->in[34], 256, 1024, WKV, 256, 0, 0, 1024);
            ADDJOB(ap->in[39], DM, DM, WOUTO, DM, 0, 0, 0);
            ADDJOB(ap->in[39] + (size_t)1024 * DM, 1024, DM, WMIXS, 5120, 4096, 0, 0);
            jst[nj] = st; jK[31] = nj;
#undef ADDJOB
        }
        __syncthreads();
        const int njobs = jK[31], total = jst[njobs];
        int jc = 0;
        for (int it = gw; it < total; it += NGW) {
            while (it >= jst[jc + 1]) ++jc;
            const GAS float* W = (const GAS float*)(uintptr_t)jsrc[jc]; GAS bf16_t* WT = (GAS bf16_t*)(uintptr_t)jdst[jc];
            const int K = jK[jc], N = jN[jc], ldt = jld[jc], coff = jco[jc], map = jmap[jc], p0 = jp0[jc], item = it - jst[jc];
            transpose_item(W, K, N, WT, ldt, coff, map, p0, item, lane);
        }
        for (long i = gt; i < (long)MT * DM / 8; i += NGT) { const long e = i * 8; const float* src = e < (long)MP * DM ? ap->in[0] + e : ap->in[1] + (e - (long)MP * DM);
            const f32x4 v0 = *(const f32x4*)src, v1 = *(const f32x4*)(src + 4); *(u32x4*)(XB + e) = pack8(v0, v1); }
        for (long i = gt; i < 512 * 1024 / 8; i += NGT) { const int s = (int)(i / 128), c = (int)(i % 128) * 8, h = c >> 6, d = c & 63; const float* src = ap->in[32] + (size_t)s * 1536 + h * 96 + d;
            *(u32x4*)(WUQN + (size_t)s * 1024 + c) = pack8(*(const f32x4*)src, *(const f32x4*)(src + 4)); }
        for (long i = gt; i < 2L * 4096 * 1024 / 8; i += NGT) { const int which = (int)(i / (4096 * 128)); const long r = i % (4096 * 128); const int mrow = (int)(r / 128), c = (int)(r % 128) * 8, h = mrow >> 8, rr = mrow & 255;
            u32x4 w = (u32x4){0u, 0u, 0u, 0u};
            if ((c >> 6) == h) { const float* src = ap->in[which ? 34 : 33] + (size_t)rr * 1024 + c; w = pack8(*(const f32x4*)src, *(const f32x4*)(src + 4)); }
            *(u32x4*)((which ? AEXPV : AEXPK) + (size_t)mrow * 1024 + c) = w; }
        for (long i = gt; i < 8 * 128 * 128; i += NGT) { const int s = (int)(i & 127), t = (int)((i >> 7) & 127); WSG[i] = (bf16_t)(s <= t ? f2bf(ap->in[37][i]) : 0u); }
        for (long i = gt; i < 16384 * 16; i += NGT) { const int pos = (int)(i >> 4), f = (int)(i & 15); const float inv = (float)dexp(-(double)f * (9.210340371976184 / 16.0)); const float ang = (float)pos * inv;
            double sn, cs; dsincos((double)ang, sn, cs); ROPE[(size_t)pos * 32 + f] = (float)cs; ROPE[(size_t)pos * 32 + 16 + f] = (float)sn; }
        for (long i = gt; i < 32 * 64 * 64; i += NGT) { const int ii = (int)(i & 63), p = (int)((i >> 6) & 63), g = (int)(i >> 12);
            const SsmLam L = ssm_lam(ap->in[18], ap->in[19], ap->in[20], g, p); double cr, ci, wr_, wi_; ssm_co(L, cr, ci); ssm_pow(L, 63 - ii, wr_, wi_);
            const double fr_ = wr_ * cr - wi_ * ci, fi_ = wr_ * ci + wi_ * cr;
            float re[16], im[16];
#pragma unroll
            for (int c = 0; c < 16; ++c) { const double br = ap->in[21][(size_t)(g * 64 + p) * 16 + c], bi = ap->in[22][(size_t)(g * 64 + p) * 16 + c]; re[c] = (float)(fr_ * br - fi_ * bi); im[c] = (float)(fr_ * bi + fi_ * br); }
            bf16_t* d0 = BT1 + ((size_t)g * 256 + p) * 1024 + (63 - ii) * 16; bf16_t* d1 = BT1 + ((size_t)g * 256 + 64 + p) * 1024 + (63 - ii) * 16;
            *(u32x4*)d0 = pack8((f32x4){re[0], re[1], re[2], re[3]}, (f32x4){re[4], re[5], re[6], re[7]}); *(u32x4*)(d0 + 8) = pack8((f32x4){re[8], re[9], re[10], re[11]}, (f32x4){re[12], re[13], re[14], re[15]});
            *(u32x4*)d1 = pack8((f32x4){im[0], im[1], im[2], im[3]}, (f32x4){im[4], im[5], im[6], im[7]}); *(u32x4*)(d1 + 8) = pack8((f32x4){im[8], im[9], im[10], im[11]}, (f32x4){im[12], im[13], im[14], im[15]}); }
        for (long i = gt; i < 32 * 64 * 64; i += NGT) { const int p = (int)(i & 63), j = (int)((i >> 6) & 63), g = (int)(i >> 12);
            const SsmLam L = ssm_lam(ap->in[18], ap->in[19], ap->in[20], g, p); double wr_, wi_; ssm_pow(L, j + 1, wr_, wi_);
#pragma unroll
            for (int c = 0; c < 16; ++c) { const double cr = ap->in[23][(size_t)(g * 16 + c) * 64 + p], ci = ap->in[24][(size_t)(g * 16 + c) * 64 + p];
                bf16_t* d = BT2 + ((size_t)g * 1024 + j * 16 + c) * 1152 + 1024 + p; d[0] = (bf16_t)f2bf((float)(cr * wr_ - ci * wi_)); d[64] = (bf16_t)f2bf((float)(-(cr * wi_ + ci * wr_))); } }
        for (long i = gt; i < 32 * 64; i += NGT) { const SsmLam L = ssm_lam(ap->in[18], ap->in[19], ap->in[20], (int)(i >> 6), (int)(i & 63)); double wr_, wi_; ssm_pow(L, 64, wr_, wi_); A64[i * 2] = (float)wr_; A64[i * 2 + 1] = (float)wi_; }
        for (int item = bx; item < 256; item += G) {
            const int g = item >> 3, kq = item & 7;
            LAS float* sB = (LAS float*)(lds + 80 * 1024);
            LAS float* sC = sB + 2048;
            LAS float* sW = sC + 2048;
            for (int e = tid; e < 1024; e += NW * 64) { const int p = e >> 4, c = e & 15; const SsmLam L = ssm_lam(ap->in[18], ap->in[19], ap->in[20], g, p); double cr, ci; ssm_co(L, cr, ci);
                const double br = ap->in[21][(size_t)(g * 64 + p) * 16 + c], bi = ap->in[22][(size_t)(g * 64 + p) * 16 + c]; sB[e * 2] = (float)(cr * br - ci * bi); sB[e * 2 + 1] = (float)(cr * bi + ci * br);
                const int c2 = e >> 6, p2 = e & 63; sC[e * 2] = ap->in[23][(size_t)(g * 16 + c2) * 64 + p2]; sC[e * 2 + 1] = ap->in[24][(size_t)(g * 16 + c2) * 64 + p2]; }
            for (int kk = 0; kk < 8; ++kk) { const int k = kq * 8 + kk;
                __syncthreads();
                if (tid < 64) { const SsmLam L = ssm_lam(ap->in[18], ap->in[19], ap->in[20], g, tid); double wr_, wi_; ssm_pow(L, k, wr_, wi_); sW[tid * 2] = (float)wr_; sW[tid * 2 + 1] = (float)wi_; }
                __syncthreads();
                if (tid < 256) { const int c = tid >> 4, cp = tid & 15; float acc = 0.f;
                    for (int p = 0; p < 64; ++p) { const float cr = sC[(c * 64 + p) * 2], ci = sC[(c * 64 + p) * 2 + 1], wr_ = sW[p * 2], wi_ = sW[p * 2 + 1], br = sB[(p * 16 + cp) * 2], bi = sB[(p * 16 + cp) * 2 + 1];
                        const float tr = cr * wr_ - ci * wi_, ti = cr * wi_ + ci * wr_; acc += tr * br - ti * bi; }
                    if (k == 0 && c == cp) acc += ap->in[25][g * 16 + c];
                    KTAB[((size_t)g * 64 + k) * 256 + tid] = acc; } }
            __syncthreads();
        }
    }
    } GRID_BAR();

#pragma clang loop unroll(disable)
    for (int sl = 0; sl < 4; ++sl) {
        const int layer = sl >> 1, f = sl & 1;
        if (sl == 1) {
            { PHASE_BEGIN();
            { pg8::Gemm g{XB, WINE, DM, DM, DM}; pg8::TileOrder S; S.init(MT / 256, 8, G, bx); pg8::EpiZe E{ZP, UP, out}; pg8::gemm_phase(lds, g, S, E); }
            if (bx >= 64 && bx < 96) { pg8::Gemm g{AEXPK, WUQN, 1024, 1024, 1024}; pg8::TileOrder S; S.init(16, 2, 32, bx - 64); pg8::EpiPlain E{WQLAT, 512}; pg8::gemm_phase(lds, g, S, E); }
            if (bx >= 96) { pg8::Gemm g{WOUTO, AEXPV, 1024, DM, 1024}; pg8::TileOrder S; S.init(8, 16, 160, bx - 96); pg8::EpiPlain E{WMIXS, 5120}; pg8::gemm_phase(lds, g, S, E); }
            } GRID_BAR(); { PHASE_BEGIN();
            { pg8::Gemm g{UP, BT1, 1024, 1152, 1024}; pg8::GroupOrder S; S.init(32, 3, 1, 3, 1, G, bx); pg8::EpiS1 E{S1}; pg8::gemm_phase(lds, g, S, E); }
            for (int it = NGW - 1 - gw; it < 2176 * 3; it += NGW) {
                const int rb = it / 3, cg = it % 3, col = cg * 512 + lane * 8, pg = col / 384, w = 2 << pg, wmax = 4 << cg;
                const int row0 = rb * 16; const bool smp = row0 >= MP; const int t0 = smp ? ((row0 - MP) & 63) : (row0 & (SEQ - 1)); const int rowb = row0 - t0;
                const bf16_t* zb = ZP + (size_t)rowb * 1536 + col; bf16_t* dp = DP + ((size_t)pg * MT + row0) * 384 + (col - pg * 384);
                const float icw = 1.f / (float)w;
                float sm[8];
#pragma unroll
                for (int e = 0; e < 8; ++e) sm[e] = 0.f;
#define UNPK(W_, F_) do { F_[0] = bflo(W_.x); F_[1] = bfhi(W_.x); F_[2] = bflo(W_.y); F_[3] = bfhi(W_.y); F_[4] = bflo(W_.z); F_[5] = bfhi(W_.z); F_[6] = bflo(W_.w); F_[7] = bfhi(W_.w); } while (0)
                if (t0 >= 15) {
                    u32x4 pz[15];
#pragma unroll
                    for (int k = 1; k < 16; ++k) pz[k - 1] = *(const u32x4*)(zb + (size_t)(t0 - (k < wmax ? k : 1)) * 1536);
#pragma unroll
                    for (int k = 1; k < 16; ++k) { float f[8]; UNPK(pz[k - 1], f); const float mk = k < w ? 1.f : 0.f;
#pragma unroll
                        for (int e = 0; e < 8; ++e) sm[e] += mk * f[e]; }
#pragma unroll
                    for (int r8 = 0; r8 < 16; r8 += 8) { u32x4 za[8], ya[8];
#pragma unroll
                        for (int i = 0; i < 8; ++i) { za[i] = *(const u32x4*)(zb + (size_t)(t0 + r8 + i) * 1536); ya[i] = *(const u32x4*)(zb + (size_t)(t0 + r8 + i - w + 1) * 1536); }
#pragma unroll
                        for (int i = 0; i < 8; ++i) { float f[8], y[8]; UNPK(za[i], f); UNPK(ya[i], y);
#pragma unroll
                            for (int e = 0; e < 8; ++e) sm[e] += f[e];
                            *(u32x4*)(dp + (size_t)(r8 + i) * 384) = pack8((f32x4){sm[0] * icw - f[0], sm[1] * icw - f[1], sm[2] * icw - f[2], sm[3] * icw - f[3]}, (f32x4){sm[4] * icw - f[4], sm[5] * icw - f[5], sm[6] * icw - f[6], sm[7] * icw - f[7]});
#pragma unroll
                            for (int e = 0; e < 8; ++e) sm[e] -= y[e]; } }
                } else {
                    const float* hist = ap->in[2] + (size_t)(smp ? ((row0 - MP) >> 6) : 0) * 15 * 1536 + col;
#define ZF8(tt, F_) do { const int tt_ = (tt); if (tt_ >= 0) { const u32x4 z_ = *(const u32x4*)(zb + (size_t)tt_ * 1536); UNPK(z_, F_); } \
                        else if (smp) { const f32x4 h0_ = *(const f32x4*)(hist + (size_t)(15 + tt_) * 1536), h1_ = *(const f32x4*)(hist + (size_t)(15 + tt_) * 1536 + 4); \
                            F_[0] = h0_[0]; F_[1] = h0_[1]; F_[2] = h0_[2]; F_[3] = h0_[3]; F_[4] = h1_[0]; F_[5] = h1_[1]; F_[6] = h1_[2]; F_[7] = h1_[3]; } \
                        else { _Pragma("unroll") for (int e_ = 0; e_ < 8; ++e_) F_[e_] = 0.f; } } while (0)
                    for (int k = 1; k < w; ++k) { float f[8]; ZF8(t0 - k, f);
#pragma unroll
                        for (int e = 0; e < 8; ++e) sm[e] += f[e]; }
                    for (int i = 0; i < 16; ++i) { const int t = t0 + i; float f[8], y[8]; ZF8(t, f); ZF8(t - w + 1, y);
                        const float ic = (smp || t + 1 >= w) ? icw : 1.f / (float)(t + 1);
#pragma unroll
                        for (int e = 0; e < 8; ++e) sm[e] += f[e];
                        *(u32x4*)(dp + (size_t)i * 384) = pack8((f32x4){sm[0] * ic - f[0], sm[1] * ic - f[1], sm[2] * ic - f[2], sm[3] * ic - f[3]}, (f32x4){sm[4] * ic - f[4], sm[5] * ic - f[5], sm[6] * ic - f[6], sm[7] * ic - f[7]});
#pragma unroll
                        for (int e = 0; e < 8; ++e) sm[e] -= y[e]; }
#undef ZF8
                }
#undef UNPK
            }
            } GRID_BAR(); { PHASE_BEGIN();
            if (wave == 0 && bx >= G - 64) {
                const int cb_ = bx - (G - 64), b = cb_ >> 5, g = cb_ & 31, p = lane; const float ar = A64[(g * 64 + p) * 2], ai = A64[(g * 64 + p) * 2 + 1];
                float hr = 0.f, hi_ = 0.f;
                for (int kb = 0; kb < 256; kb += 16) { float sr[16], si[16];
#pragma unroll
                    for (int j = 0; j < 16; ++j) { const size_t row = (size_t)g * 768 + b * 256 + kb + j; sr[j] = S1[row * 128 + p]; si[j] = S1[row * 128 + 64 + p]; }
#pragma unroll
                    for (int j = 0; j < 16; ++j) { const size_t row = (size_t)g * 768 + b * 256 + kb + j;
                        UP[row * 1152 + 1024 + p] = (bf16_t)f2bf(hr); UP[row * 1152 + 1088 + p] = (bf16_t)f2bf(hi_);
                        const float nr = ar * hr - ai * hi_ + sr[j], ni = ar * hi_ + ai * hr + si[j]; hr = nr; hi_ = ni; } }
                out[O_SREP + (size_t)(b * 32 + g) * 64 + p] = hr; out[O_SIMP + (size_t)(b * 32 + g) * 64 + p] = hi_;
            } else if (bx >= 64 && bx < G - 64) {
                const int it = (bx - 64) * NW + wave;
                if (it < 1024) { const int b = it >> 5, g = it & 31, p = lane; const float ar = A64[(g * 64 + p) * 2], ai = A64[(g * 64 + p) * 2 + 1];
                    const float hr = ap->in[3][(size_t)(b * 32 + g) * 64 + p], hi_ = ap->in[4][(size_t)(b * 32 + g) * 64 + p]; const size_t row = (size_t)g * 768 + 512 + b;
                    UP[row * 1152 + 1024 + p] = (bf16_t)f2bf(hr); UP[row * 1152 + 1088 + p] = (bf16_t)f2bf(hi_);
                    const float sr = S1[row * 128 + p], si = S1[row * 128 + 64 + p];
                    out[O_SRES + (size_t)(b * 32 + g) * 64 + p] = ar * hr - ai * hi_ + sr; out[O_SIMS + (size_t)(b * 32 + g) * 64 + p] = ar * hi_ + ai * hr + si; }
            }
            { pg8::Gemm g{DP, WPOOL, 384, 384, 384}; pg8::GroupOrder S;
              if (G != 256) S.init(4, MT / 256, 2, MT / 256, 2, G, bx);
              else if (bx < 192) { S.init(4, MT / 256, 2, MT / 256, 2, 192, bx); S.total = 960; }
              else S.init(4, MT / 256, 2, MT / 256, 2, 64, 960 + bx - 192);
              pg8::EpiPool E{MIX, ap->in[17]}; pg8::gemm_phase(lds, g, S, E); }
            } GRID_BAR(); { PHASE_BEGIN();
            { pg8::Gemm g{UP, BT2, 1152, 1152, 1152}; pg8::EpiS2 E{GACT};
              if (G == 256) { pg8::S5Order S; S.init(bx); pg8::gemm_phase(lds, g, S, E); }
              else { pg8::GroupOrder S; S.init(32, 3, 4, 3, 4, G, bx); pg8::gemm_phase(lds, g, S, E); } }
            } GRID_BAR(); { PHASE_BEGIN();
            { pg8::Gemm g{GACT, WGLU, 512, 512, 512}; pg8::TileOrder S; S.init(MT / 256, 2, G, bx); pg8::EpiGlu E{GACT, ap->in[27], MIX}; pg8::gemm_phase(lds, g, S, E); }
            } GRID_BAR(); { PHASE_BEGIN();
            { pg8::Gemm g{MIX, WOUTE, DM, DM, DM}; pg8::SplitOrder S; S.init(MP / 256, MS / 256, 8, MP / 256, DM / 256, G, bx); pg8::EpiResid E{XB, TB, 1.f, 0, PART}; pg8::gemm_phase(lds, g, S, E); }
            } GRID_BAR();
        }
        if (sl == 3) {
            { PHASE_BEGIN();
            { pg8::Gemm g{XB, WINO, DM, DM, DM}; pg8::TileOrder S; S.init(MT / 256, 12, G, bx); pg8::EpiZo E{ZQ, ZC, ZK, UB, VPRE}; pg8::gemm_phase(lds, g, S, E); }
            } GRID_BAR(); { PHASE_BEGIN();
            for (long i0 = gt; i0 < 32L * 4096 * 36; i0 += 4 * NGT) {
                f32x4 ca[4], cb[4];
#pragma unroll
                for (int k = 0; k < 4; ++k) { const long i = i0 + k * NGT; if (i < 32L * 4096 * 36) { const int ch = (int)(i % 36); const long rowc = i / 36;
                    const float* src = ch < 32 ? ap->in[5] + (size_t)rowc * 256 + ch * 8 : ap->in[6] + (size_t)rowc * 32 + (ch - 32) * 8; ca[k] = *(const f32x4*)src; cb[k] = *(const f32x4*)(src + 4); } else { ca[k] = f32x4{}; cb[k] = f32x4{}; } }
#pragma unroll
                for (int k = 0; k < 4; ++k) { const long i = i0 + k * NGT; if (i < 32L * 4096 * 36) { const int ch = (int)(i % 36); const long rowc = i / 36; const int b = (int)(rowc >> 12), t = (int)(rowc & 4095);
                    *(u32x4*)(KXS + ((size_t)b * 4160 + t) * 288 + ch * 8) = pack8(ca[k], cb[k]); } }
            }
            const f32x4 gq0 = *(const f32x4*)(ap->in[30] + 4 * lane), gq1 = *(const f32x4*)(ap->in[30] + 256 + 4 * lane), gkv = *(const f32x4*)(ap->in[31] + 4 * lane);
            f32x4 gv[4], bv[4];
#pragma unroll
            for (int hf = 0; hf < 2; ++hf) { const int c0 = hf * 512 + 8 * lane; gv[2 * hf] = *(const f32x4*)(ap->in[35] + c0); gv[2 * hf + 1] = *(const f32x4*)(ap->in[35] + c0 + 4); bv[2 * hf] = *(const f32x4*)(ap->in[36] + c0); bv[2 * hf + 1] = *(const f32x4*)(ap->in[36] + c0 + 4); }
            for (int row = gw; row < MT; row += NGW) {
                const bool smp = row >= MP; const int rs = row - MP, sb = rs >> 6, st = rs & 63; const int pos = smp ? 4096 + st : (row & (SEQ - 1));
                bf16_t* kx = KXS + ((size_t)sb * 4160 + 4096 + st) * 288;
                const float* zq = ZQ + (size_t)row * 512; const f32x4 q0 = *(const f32x4*)(zq + 4 * lane), q1 = *(const f32x4*)(zq + 256 + 4 * lane);
                const f32x4 cv = *(const f32x4*)(ZC + (size_t)row * 256 + 4 * lane);
                const bf16_t* zv = VPRE + (size_t)row * 1024; const u32x4 wa = *(const u32x4*)(zv + 8 * lane), wb = *(const u32x4*)(zv + 512 + 8 * lane);
                float x1 = 0.f, x2 = 0.f, cs = 0.f, sn = 0.f;
                if (lane < 16) { x1 = ZK[(size_t)row * 32 + lane]; x2 = ZK[(size_t)row * 32 + 16 + lane]; cs = ROPE[(size_t)pos * 32 + lane]; sn = ROPE[(size_t)pos * 32 + 16 + lane]; }
                float v[16] = {bflo(wa.x), bfhi(wa.x), bflo(wa.y), bfhi(wa.y), bflo(wa.z), bfhi(wa.z), bflo(wa.w), bfhi(wa.w), bflo(wb.x), bfhi(wb.x), bflo(wb.y), bfhi(wb.y), bflo(wb.z), bfhi(wb.z), bflo(wb.w), bfhi(wb.w)};
                float ssq = (q0[0] * q0[0] + q0[1] * q0[1]) + (q0[2] * q0[2] + q0[3] * q0[3]) + (q1[0] * q1[0] + q1[1] * q1[1]) + (q1[2] * q1[2] + q1[3] * q1[3]);
                float ssc = (cv[0] * cv[0] + cv[1] * cv[1]) + (cv[2] * cv[2] + cv[3] * cv[3]);
                float sv = 0.f;
#pragma unroll
                for (int e = 0; e < 16; ++e) sv += v[e];
                ssq = wave_sum(ssq); ssc = wave_sum(ssc); sv = wave_sum(sv);
                const float mu = sv * (1.f / 1024); float s2 = 0.f;
#pragma unroll
                for (int e = 0; e < 16; ++e) { v[e] -= mu; s2 += v[e] * v[e]; }
                { const float r = 1.f / sqrtf(ssq * (1.f / 512) + RMS_EPS);
                  const f32x4 o0 = q0 * r * gq0, o1 = q1 * r * gq1; u32x2 w0, w1; w0.x = pk2(o0[0], o0[1]); w0.y = pk2(o0[2], o0[3]); w1.x = pk2(o1[0], o1[1]); w1.y = pk2(o1[2], o1[3]);
                  *(u32x2*)(CQN + (size_t)row * 512 + 4 * lane) = w0; *(u32x2*)(CQN + (size_t)row * 512 + 256 + 4 * lane) = w1; }
                { const float r = 1.f / sqrtf(ssc * (1.f / 256) + RMS_EPS); const f32x4 o = cv * r * gkv;
                  *(f32x4*)(out + (smp ? O_CKVS + (size_t)rs * 256 : O_CKVP + (size_t)row * 256) + 4 * lane) = o;
                  u32x2 w; w.x = pk2(o[0], o[1]); w.y = pk2(o[2], o[3]); *(u32x2*)((smp ? kx : CKVB + (size_t)row * 256) + 4 * lane) = w; }
                if (lane < 16) {
                  const float o1 = x1 * cs - x2 * sn, o2 = x2 * cs + x1 * sn; float* op = out + (smp ? O_KPES + (size_t)rs * 32 : O_KPEP + (size_t)row * 32); op[lane] = o1; op[16 + lane] = o2;
                  bf16_t* kb = smp ? kx + 256 : KPEB + (size_t)row * 32; kb[lane] = (bf16_t)f2bf(o1); kb[16 + lane] = (bf16_t)f2bf(o2); }
                { const float r = 1.f / sqrtf(wave_sum(s2) * (1.f / 1024) + LN_EPS);
#pragma unroll
                  for (int hf = 0; hf < 2; ++hf) { const int c0 = hf * 512 + 8 * lane; const f32x4 g0 = gv[2 * hf], g1 = gv[2 * hf + 1], b0 = bv[2 * hf], b1 = bv[2 * hf + 1];
                      const f32x4 o0 = (f32x4){v[hf * 8 + 0], v[hf * 8 + 1], v[hf * 8 + 2], v[hf * 8 + 3]} * r * g0 + b0, o1 = (f32x4){v[hf * 8 + 4], v[hf * 8 + 5], v[hf * 8 + 6], v[hf * 8 + 7]} * r * g1 + b1;
                      *(u32x4*)(VB + (size_t)row * 1024 + c0) = pack8(o0, o1);
                      if (smp) { float* op = out + O_SGVS + (size_t)rs * 1024 + c0; *(f32x4*)op = o0; *(f32x4*)(op + 4) = o1; } } }
            }
            } GRID_BAR(); { PHASE_BEGIN();
            { pg8::Gemm g{CQN, WUQ, 512, 512, 512}; pg8::TileOrder S; S.init(MP / 256, 6, G, bx); pg8::EpiQ E{QP, QS, ROPE}; pg8::gemm_phase(lds, g, S, E); }
            { pg8::Gemm g{CQN, WUQ, 512, 512, 512}; pg8::TileOrder S; S.init(MS / 256, 2, G, bx, MP / 256, 4); pg8::EpiQ E{QP, QS, ROPE}; pg8::gemm_phase(lds, g, S, E); }
            { pg8::Gemm g{CQN + (size_t)MP * 512, WQLAT, 512, 512, 512}; pg8::TileOrder S; S.init(MS / 256, 16, G, bx >= G / 2 ? bx - G / 2 : bx + G / 2); pg8::EpiQlat E{QS}; pg8::gemm_phase(lds, g, S, E); }
            { pg8::Gemm g{CKVB, WKV, 256, 256, 256}; pg8::TileOrder S; S.init(MP / 256, 8, G, bx); pg8::EpiKV E{KP, VP}; pg8::gemm_phase(lds, g, S, E); }
            {
                constexpr int RS = 320, IMG = 128 * RS;
                char* sl = (char*)lds_raw;
                const int tb = wave >> 1, cbp = wave & 1, r32 = lane & 31, hi = lane >> 5;
                const int vrd = (int)(unsigned)(uintptr_t)sl + (8 * hi + ((lane >> 2) & 3)) * RS + (64 * cbp + 16 * ((lane >> 4) & 1) + 4 * (lane & 3)) * 2;
                u32x4 sv[4];
#define SG_LOAD(un_) do { const bool smp_ = (un_) >= 2048; const int ch_ = smp_ ? ((un_) - 2048) >> 3 : (un_) >> 3, g_ = (un_) & 7, rb_ = smp_ ? MP + ch_ * 64 : ch_ * 128, nr_ = smp_ ? 64 : 128; \
                    _Pragma("unroll") for (int k = 0; k < 4; ++k) { const int idx = tid + 512 * k, row = (idx >> 4) & (nr_ - 1); sv[k] = *(const u32x4*)(VB + (size_t)(rb_ + row) * 1024 + g_ * 128 + (idx & 15) * 8); } } while (0)
#define SG_WRITE(bf_) do { _Pragma("unroll") for (int k = 0; k < 4; ++k) { const int idx = tid + 512 * k, row = idx >> 4; *(u32x4*)(sl + (bf_) * IMG + row * RS + (idx & 15) * 16) = sv[k]; } } while (0)
                __syncthreads();
                int un = vcu, bf = 0;
                SG_LOAD(un); SG_WRITE(0);
                __syncthreads();
                for (; un < 2048 + 256; un += G, bf ^= 1) {
                    const int unn = un + G; const bool more = unn < 2048 + 256;
                    { const int unl = more ? unn : un; SG_LOAD(unl); }
                    const bool smp = un >= 2048; const int ch = smp ? (un - 2048) >> 3 : un >> 3, g = un & 7; const int rowbase = smp ? MP + ch * 64 : ch * 128;
                    if (!(smp && tb >= 2)) {
                        f32x16 c0 = f32x16{}, c1 = f32x16{};
                        const int nks = 2 * (tb + 1); const int vb = vrd + bf * IMG;
                        const bf16_t* wp = WSG + ((size_t)g * 128 + 32 * tb + r32) * 128 + 8 * hi;
                        for (int ks = 0; ks < nks; ++ks) {
                            const bf16x8 wf = *(const bf16x8*)(wp + 16 * ks);
                            const int va = vb + ks * 16 * RS;
                            const s16x4 l0 = att::tr_read<0>(va), h0 = att::tr_read<4 * RS>(va), l1 = att::tr_read<64>(va), h1 = att::tr_read<4 * RS + 64>(va);
                            asm volatile("s_waitcnt lgkmcnt(0)" ::: "memory"); __builtin_amdgcn_sched_barrier(0);
#define PK(L, H) (bf16x8){L[0], L[1], L[2], L[3], H[0], H[1], H[2], H[3]}
                            c0 = __builtin_amdgcn_mfma_f32_32x32x16_bf16(PK(l0, h0), wf, c0, 0, 0, 0); c1 = __builtin_amdgcn_mfma_f32_32x32x16_bf16(PK(l1, h1), wf, c1, 0, 0, 0);
#undef PK
                        }
                        const int t = 32 * tb + r32; const float bs = ap->in[38][g * 128 + t]; const size_t row = (size_t)(rowbase + t);
                        const bf16_t* up = UB + row * 1024 + g * 128 + 64 * cbp + 4 * hi;
                        bf16_t* op = (smp ? AS + (size_t)(row - MP) * 5120 + 4096 : MIX + row * DM + 1024) + g * 128 + 64 * cbp + 4 * hi;
#pragma unroll
                        for (int i = 0; i < 4; ++i) {
                            const u32x2 ua = *(const u32x2*)(up + 8 * i), ub = *(const u32x2*)(up + 32 + 8 * i); u32x2 oa, ob;
                            oa.x = pk2((c0[4 * i + 0] + bs) * bflo(ua.x), (c0[4 * i + 1] + bs) * bfhi(ua.x)); oa.y = pk2((c0[4 * i + 2] + bs) * bflo(ua.y), (c0[4 * i + 3] + bs) * bfhi(ua.y));
                            ob.x = pk2((c1[4 * i + 0] + bs) * bflo(ub.x), (c1[4 * i + 1] + bs) * bfhi(ub.x)); ob.y = pk2((c1[4 * i + 2] + bs) * bflo(ub.y), (c1[4 * i + 3] + bs) * bfhi(ub.y));
                            *(u32x2*)(op + 8 * i) = oa; *(u32x2*)(op + 32 + 8 * i) = ob; }
                    }
                    SG_WRITE(bf ^ 1);
                    __syncthreads();
                }
#undef SG_LOAD
#undef SG_WRITE
            }
            } GRID_BAR(); { PHASE_BEGIN();
            {
                char* ldsg = (char*)lds_raw;
                const int r32 = lane & 31, hi = lane >> 5;
                { const int bh = vcu >> 3, s = vcu & 7, b = bh >> 4, h = bh & 15;
                  for (int i = 0; i < 8; ++i) { const int x = s + 8 * (i >> 1), qb = (i & 1) ? 63 - x : x; const size_t rb = (size_t)b * SEQ;
                      const size_t qrow = rb + (size_t)qb * 256 + wave * 32;
                      att::attn_unit_p2(ldsg, QP + (qrow + r32) * 1536 + h * 96 + hi * 8, KP + rb * 1024 + h * 64, KPEB + rb * 32, VP + rb * 1024 + h * 64, 4 * (qb + 1), 4 * qb + (wave >> 1), MIX + qrow * DM + h * 64, DM); } }
                { const int b = vcu >> 3, hp = vcu & 7, wq = wave & 3, wd = wave >> 2, head = 2 * hp + (wq >> 1); const size_t srow0 = (size_t)b * 64 + 32 * (wq & 1);
                  att::attn_unit<true>(ldsg, QS + (srow0 + r32) * 4608 + head * 288 + hi * 8, KXS + (size_t)b * 4160 * 288, nullptr, 65, 1 << 30,
                                       AS + srow0 * 5120 + head * 256 + 128 * wd, 5120, 4 * wd); }
            }
            } GRID_BAR(); { PHASE_BEGIN();
            { pg8::Gemm g{MIX, WOUTO, DM, DM, DM}; pg8::TileOrder S; S.init(MP / 256, 8, G, bx); pg8::EpiResid E{XB, TB, 1.f, 0, PART}; pg8::gemm_phase(lds, g, S, E); }
            { pg8::Gemm g{AS, WMIXS, 5120, 5120, 5120}; pg8::SplitOrder S; S.init(0, MS / 256, 8, 0, 5120 / 256, G, bx); pg8::EpiResid E{XB, TB, 1.f, MP, PART}; pg8::gemm_phase(lds, g, S, E); }
            } GRID_BAR();
        }
        if (sl == 1 || sl == 3) {
            { PHASE_BEGIN();
            ln_pass(TB, XB, nullptr, PART, 1.f, ap->in[7] + (size_t)(layer * 3 + 1) * DM, ap->in[8] + (size_t)(layer * 3 + 1) * DM, gw, NGW, lane);
            } GRID_BAR();
        }
        { PHASE_BEGIN();
        { pg8::Gemm g{XB, WUP + (size_t)sl * 11264 * DM, DM, DM, DM}; pg8::TileOrder S; S.init(MT / 256, 44, G, bx); pg8::EpiSwiglu E{HB}; pg8::gemm_phase(lds, g, S, E); }
        if (sl < 3 && bx >= 96) {
            const int idx = sl + 1, l2 = idx >> 1, f2 = idx & 1, lw = (bx - 96) * NW + wave, nlw = (G - 96) * NW;
            const GAS float* w1 = (const GAS float*)(ap->in[9 + 3 * f2] + (size_t)l2 * DM * FF); const GAS float* w3 = (const GAS float*)(ap->in[10 + 3 * f2] + (size_t)l2 * DM * FF); const GAS float* w2 = (const GAS float*)(ap->in[11 + 3 * f2] + (size_t)l2 * FF * DM);
            GAS bf16_t* du = (GAS bf16_t*)(WUP + (size_t)idx * 11264 * DM); GAS bf16_t* dd = (GAS bf16_t*)(WDN + (size_t)idx * DM * FF);
            for (int it = lw; it < 3 * 704; it += nlw) {
                if (it < 704) transpose_item(w1, DM, FF, du, DM, 0, 1, 0, it, lane);
                else if (it < 1408) transpose_item(w3, DM, FF, du, DM, 0, 1, 128, it - 704, lane);
                else transpose_item(w2, FF, DM, dd, FF, 0, 0, 0, it - 1408, lane); }
        }
        } GRID_BAR(); { PHASE_BEGIN();
        { pg8::Gemm g{HB, WDN + (size_t)sl * DM * FF, FF, FF, FF}; pg8::SplitOrder S; S.init(MP / 256, MS / 256, 8, MP / 256, FF / 256, G, bx);
          pg8::EpiResid E{XB, sl == 3 ? TFIN : TB, 0.5f, 0, PART}; pg8::gemm_phase(lds, g, S, E); }
        } GRID_BAR(); { PHASE_BEGIN();
            ln_pass(sl == 3 ? TFIN : TB, XB, sl == 3 ? out : nullptr, PART, 0.5f, ap->in[7] + (size_t)(layer * 3 + 2 * f) * DM, ap->in[8] + (size_t)(layer * 3 + 2 * f) * DM, gw, NGW, lane);
            if (sl == 0) {
                for (long i = gt; i < 32L * 1024 * 128; i += NGT) { const int kc = (int)(i & 127), n = (int)((i >> 7) & 1023), g = (int)(i >> 17); const int j = n >> 4, c = n & 15, ii = 63 - (kc >> 1), cp = (kc & 1) * 8;
                    u32x4 w = (u32x4){0u, 0u, 0u, 0u};
                    if (ii <= j) { const float* kt = KTAB + ((size_t)g * 64 + (j - ii)) * 256 + c * 16 + cp; w = pack8(*(const f32x4*)kt, *(const f32x4*)(kt + 4)); }
                    *(u32x4*)(BT2 + ((size_t)g * 1024 + n) * 1152 + kc * 8) = w; }
            }
        } GRID_BAR();
    }
}

extern "C" void kernel_launch(void* const* d_in, const int* in_sizes, int n_in, void* d_out, int out_size, void* d_ws, size_t ws_size, hipStream_t stream) {
    static int grid = 0;
    if (grid == 0) {
        if (n_in != 40 || ws_size < WS_END) { fprintf(stderr, "kernel_launch: expected 40 inputs and >= %zu bytes of workspace; got %d, %zu\n", (size_t)WS_END, n_in, ws_size); grid = -1; return; }
        int dev = 0, cus = 0, per_cu = 0;
        if (hipGetDevice(&dev) != hipSuccess || hipDeviceGetAttribute(&cus, hipDeviceAttributeMultiprocessorCount, dev) != hipSuccess) { grid = -1; return; }
        if (hipFuncSetAttribute((const void*)fwd_kernel, hipFuncAttributeMaxDynamicSharedMemorySize, LDS_BYTES) != hipSuccess) { fprintf(stderr, "kernel_launch: hipFuncSetAttribute failed\n"); grid = -1; return; }
        if (hipOccupancyMaxActiveBlocksPerMultiprocessor(&per_cu, (const void*)fwd_kernel, NW * 64, LDS_BYTES) != hipSuccess || per_cu < 1) fprintf(stderr, "kernel_launch: occupancy query reports %d\n", per_cu);
        (void)hipGetLastError();
        grid = cus;
    }
    if (grid < 0) return;
    (void)hipMemsetAsync((char*)d_ws + WS_CTL, 0, CTL_ZERO_BYTES, stream);
    Args a{};
    for (int i = 0; i < 40; ++i) a.in[i] = (const float*)d_in[i];
    a.out = (float*)d_out; a.ws = (unsigned char*)d_ws;
    hipLaunchKernelGGL(fwd_kernel, dim3(grid), dim3(NW * 64), LDS_BYTES, stream, a);
    const hipError_t le = hipPeekAtLastError();
    if (le != hipSuccess) fprintf(stderr, "kernel_launch: launch failed: %s\n", hipGetErrorName(le));
}
```

```cpp
#include <hip/hip_runtime.h>
#include <cstdio>
#include <cstdint>

#define LAS __attribute__((address_space(3)))
#define GAS __attribute__((address_space(1)))
typedef unsigned short bf16_t;
typedef short bf16x8 __attribute__((ext_vector_type(8)));
typedef short s16x4 __attribute__((ext_vector_type(4)));
typedef float f32x4 __attribute__((ext_vector_type(4)));
typedef float f32x16 __attribute__((ext_vector_type(16)));
typedef unsigned u32x4 __attribute__((ext_vector_type(4)));
typedef unsigned u32x2 __attribute__((ext_vector_type(2)));

constexpr int DM = 2048, SEQ = 16384, MP = 2 * SEQ, MS = 32 * 64, MT = MP + MS, FF = 5632;
constexpr float ALPHA = 1.4142135623730951f;
constexpr float LN_EPS = 1e-5f, RMS_EPS = 1e-6f;
constexpr float C2 = 0.10206207261596575f * 1.4426950408889634f;
constexpr int NW = 8;

constexpr size_t O_YP = 0, O_YS = 67108864, O_POOLP = 71303168, O_SREP = 71349248, O_SIMP = 71353344, O_CKVP = 71357440, O_KPEP = 79746048,
                 O_POOLS = 80794624, O_SRES = 81531904, O_SIMS = 81597440, O_CKVS = 81662976, O_KPES = 82187264, O_SGVS = 82252800;

constexpr size_t MiB = 1u << 20;
constexpr size_t WS_CTL = 0, CTL_ZERO_BYTES = 32768;
constexpr size_t WS_ROPE = 1 * MiB, WS_KTAB = 3 * MiB, WS_A64 = 5 * MiB;
constexpr size_t WS_WUP = 8 * MiB, WS_WDN = 184 * MiB;
constexpr size_t WS_WINE = 272 * MiB, WS_WOUTE = 280 * MiB, WS_WINO = 288 * MiB, WS_WOUTO = 300 * MiB, WS_WMIXS = 308 * MiB, WS_AEXPK = 328 * MiB, WS_AEXPV = 336 * MiB,
                 WS_WQLAT = 344 * MiB, WS_WPOOL = 348 * MiB, WS_WUQ = 350 * MiB, WS_WKV = 352 * MiB, WS_WUQN = 353 * MiB, WS_WGLU = 354 * MiB, WS_WSG = 355 * MiB;
constexpr size_t WS_BT1 = 356 * MiB, WS_BT2 = 372 * MiB;
constexpr size_t WS_XB = 444 * MiB;
constexpr size_t WS_SCR = 580 * MiB;
constexpr size_t WS_H = WS_SCR;
constexpr size_t WS_ZP = 580 * MiB, WS_DP = 682 * MiB, WS_UP = 784 * MiB, WS_S1 = 838 * MiB, WS_GACT = 850 * MiB;
constexpr size_t WS_ZQ = 580 * MiB, WS_ZC = 648 * MiB, WS_ZK = 682 * MiB, WS_UB = 688 * MiB, WS_VPRE = 756 * MiB, WS_VB = 824 * MiB, WS_CQN = 892 * MiB, WS_CKVB = 926 * MiB,
                 WS_KPEB = 942 * MiB, WS_AS = 756 * MiB;
constexpr size_t WS_PART = 954 * MiB;
constexpr size_t WS_KP = 580 * MiB;
constexpr size_t WS_QP = 8 * MiB, WS_QS = 104 * MiB, WS_VP = 184 * MiB, WS_KXS = 356 * MiB;
constexpr size_t WS_END = 1024 * MiB;

constexpr int CW_TMO = 0, CW_BAR = 4096;
constexpr int LDS_BYTES = 147456, LDSCTL_OFF = 147456 - 256;

__device__ __forceinline__ unsigned f2bf(float f) { unsigned u = __builtin_bit_cast(unsigned, f); return (u + 0x7fffu + ((u >> 16) & 1u)) >> 16; }
typedef float f32x2_t __attribute__((ext_vector_type(2))); typedef __bf16 bf16x2_t __attribute__((ext_vector_type(2)));
__device__ __forceinline__ unsigned pk2(float lo, float hi) { const f32x2_t v = {lo, hi}; const bf16x2_t b = __builtin_convertvector(v, bf16x2_t); return __builtin_bit_cast(unsigned, b); }
__device__ __forceinline__ float bf2f(unsigned short u) { return __builtin_bit_cast(float, (unsigned)u << 16); }
__device__ __forceinline__ float bflo(unsigned w) { return __builtin_bit_cast(float, w << 16); }
__device__ __forceinline__ float bfhi(unsigned w) { return __builtin_bit_cast(float, w & 0xffff0000u); }
__device__ __forceinline__ void half_swap(float x, float& lo, float& hi) {
    unsigned a = __builtin_bit_cast(unsigned, x), b = a;
    asm volatile("s_nop 1\n\tv_permlane32_swap_b32 %0, %1\n\ts_nop 1" : "+v"(a), "+v"(b));
    lo = __builtin_bit_cast(float, a); hi = __builtin_bit_cast(float, b);
}
#define DPP_ADD(v, ctrl) v += __builtin_bit_cast(float, __builtin_amdgcn_update_dpp(0, __builtin_bit_cast(int, v), ctrl, 0xf, 0xf, false))
__device__ __forceinline__ float wave_sum(float v) {
    DPP_ADD(v, 0xB1); DPP_ADD(v, 0x4E); DPP_ADD(v, 0x141); DPP_ADD(v, 0x140);
    v += __builtin_bit_cast(float, __builtin_amdgcn_ds_swizzle(__builtin_bit_cast(int, v), (16 << 10) | 0x1f));
    float lo, hi; half_swap(v, lo, hi); return lo + hi;
}
__device__ __forceinline__ float ex2(float x) { return __builtin_amdgcn_exp2f(x); }
__device__ __forceinline__ float sigmoidf_(float x) { return __builtin_amdgcn_rcpf(1.f + ex2(-1.4426950408889634f * x)); }
__device__ __forceinline__ float siluf_(float x) { return x * sigmoidf_(x); }
__device__ __forceinline__ float gelu_tanh(float y) { const float z = 0.7978845608028654f * (y + 0.044715f * y * y * y); const float t = 1.f - 2.f * __builtin_amdgcn_rcpf(1.f + ex2(2.885390081777927f * z)); return 0.5f * y * (1.f + t); }
__device__ __forceinline__ u32x4 pack8(f32x4 a, f32x4 b) { u32x4 w; w.x = pk2(a[0], a[1]); w.y = pk2(a[2], a[3]); w.z = pk2(b[0], b[1]); w.w = pk2(b[2], b[3]); return w; }
__device__ __forceinline__ void dsincos(double x, double& s, double& c) {
    const double k = rint(x * 0.6366197723675814); const double y = x - k * 1.5707963267948966192;
    const double y2 = y * y;
    const double sy = y * (1.0 + y2 * (-1.0 / 6 + y2 * (1.0 / 120 + y2 * (-1.0 / 5040 + y2 * (1.0 / 362880 + y2 * (-1.0 / 39916800 + y2 * (1.0 / 6227020800.0)))))));
    const double cy = 1.0 + y2 * (-0.5 + y2 * (1.0 / 24 + y2 * (-1.0 / 720 + y2 * (1.0 / 40320 + y2 * (-1.0 / 3628800 + y2 * (1.0 / 479001600.0))))));
    const int q = ((int)(long long)k) & 3;
    s = (q == 0) ? sy : (q == 1) ? cy : (q == 2) ? -sy : -cy;
    c = (q == 0) ? cy : (q == 1) ? -sy : (q == 2) ? -cy : sy;
}
__device__ __forceinline__ double dexp(double x) {
    const double n = rint(x * 1.4426950408889634); const double r = x - n * 0.6931471805599453094;
    double p = 1.0 / 479001600.0;
    p = p * r + 1.0 / 39916800; p = p * r + 1.0 / 3628800; p = p * r + 1.0 / 362880; p = p * r + 1.0 / 40320; p = p * r + 1.0 / 5040; p = p * r + 1.0 / 720;
    p = p * r + 1.0 / 120; p = p * r + 1.0 / 24; p = p * r + 1.0 / 6; p = p * r + 0.5; p = p * r + 1.0; p = p * r + 1.0;
    return ldexp(p, (int)n);
}

namespace pg8 {
constexpr int BM = 256, BK = 64, HALF = 128, HTB = HALF * BK * 2, NXCD = 8, WGM = 8;
__host__ __device__ __forceinline__ int lds_byte(int r, int c) { const int st = (r >> 4) * 2 + (c >> 5), rr = r & 15, cc = c & 31, ob = rr * 64 + cc * 2; return st * 1024 + (ob ^ (((ob >> 9) & 1) << 5)); }
__host__ __device__ __forceinline__ void stage_rc(int b, int& R, int& C) { const int st = b / 1024, sb = b % 1024, swz = sb ^ (((sb >> 9) & 1) << 5); R = (st >> 1) * 16 + swz / 64; C = (st & 1) * 32 + (swz % 64) / 2; }
__host__ __device__ __forceinline__ int perm32(int rho) { const int n = rho >> 4, i = rho & 15; return 8 * (i >> 2) + 4 * n + (i & 3); }

struct Unit { int pm, pn, g, lm, ln, kofs, nt; };
struct Gemm { const bf16_t* A; const bf16_t* Bt; int K, lda, ldb; };

struct TileOrder {
    int nM, nN, nwg, G, c, pm0, pn0;
    __device__ __forceinline__ void init(int nM_, int nN_, int G_, int c_, int pm0_ = 0, int pn0_ = 0) { nM = nM_; nN = nN_; nwg = nM * nN; G = G_; c = c_; pm0 = pm0_; pn0 = pn0_; }
    __device__ __forceinline__ bool next(int i, Unit& u) const {
        const long L = (long)i * G + c; if (L >= nwg) return false;
        int wgid = (int)L; { const int q = nwg / NXCD, r = nwg % NXCD, xcd = wgid % NXCD, off = wgid / NXCD; wgid = (xcd < r ? xcd * (q + 1) : r * (q + 1) + (xcd - r) * q) + off; }
        const int nig = WGM * nN, gid = wgid / nig, fm = gid * WGM, gsz = (nM - fm) < WGM ? (nM - fm) : WGM;
        const int pm = fm + ((wgid % nig) % gsz), pn = (wgid % nig) / gsz;
        u.pm = pm0 + pm; u.pn = pn0 + pn; u.g = 0; u.lm = pm; u.ln = pn; u.kofs = 0; u.nt = 0; return true;
    }
    __device__ __forceinline__ void a_ready(const Unit&) const {}
    __device__ __forceinline__ void done(const Unit&) const {}
};
struct SplitOrder {
    TileOrder T; int nfull, nsplit, nN, pms0, ntq, G, c;
    __device__ __forceinline__ void init(int nMf, int nMs, int nN_, int pms0_, int ntq_, int G_, int c_) { T.init(nMf, nN_, G_, c_); nfull = nMf * nN_; nsplit = nMs * nN_ * 4; nN = nN_; pms0 = pms0_; ntq = ntq_; G = G_; c = c_; }
    __device__ __forceinline__ bool next(int i, Unit& u) const {
        const long L = (long)i * G + c;
        if (L < nfull) return T.next(i, u);
        const int s_ = (int)(L - nfull); if (s_ >= nsplit) return false;
        const int kq = s_ & 3, tile = s_ >> 2, pm = tile / nN, pn = tile - pm * nN;
        u.pm = pms0 + pm; u.pn = pn; u.g = kq; u.lm = pm; u.ln = pn; u.kofs = kq * ntq * 64; u.nt = ntq; return true;
    }
    __device__ __forceinline__ void a_ready(const Unit&) const {}
    __device__ __forceinline__ void done(const Unit&) const {}
};
struct S5Order {
    int c;
    __device__ __forceinline__ void init(int c_) { c = c_; }
    __device__ __forceinline__ bool next(int i, Unit& u) const {
        int q, ln;
        if (c < 96) { if (i > 0) return false; q = c; ln = 3; }
        else if (c < 192) { if (i > 1) return false; q = c - 96; ln = i == 0 ? 2 : 0; }
        else if (c < 240) { if (i > 1) return false; q = 2 * (c - 192) + i; ln = 1; }
        else return false;
        const int g = q / 3, lm = q - 3 * g;
        u.pm = g * 3 + lm; u.pn = g * 4 + ln; u.g = g; u.lm = lm; u.ln = ln; u.kofs = 768 - 256 * ln; u.nt = 6 + 4 * ln; return true;
    }
    __device__ __forceinline__ void a_ready(const Unit&) const {}
    __device__ __forceinline__ void done(const Unit&) const {}
};
struct GroupOrder {
    int nMg, nNg, per, total, G, c, sA, sB;
    __device__ __forceinline__ void init(int ng, int nMg_, int nNg_, int sA_, int sB_, int G_, int c_) { nMg = nMg_; nNg = nNg_; per = nMg * nNg; total = ng * per; sA = sA_; sB = sB_; G = G_; c = c_; }
    __device__ __forceinline__ bool next(int i, Unit& u) const {
        const long L = (long)i * G + c; if (L >= total) return false;
        const int g = (int)L / per, r = (int)L % per, lm = r / nNg, ln = r % nNg;
        u.pm = g * sA + lm; u.pn = g * sB + ln; u.g = g; u.lm = lm; u.ln = ln; u.kofs = 0; u.nt = 0; return true;
    }
    __device__ __forceinline__ void a_ready(const Unit&) const {}
    __device__ __forceinline__ void done(const Unit&) const {}
};

template <class Epi, class Sched>
__device__ __forceinline__ void gemm_phase(LAS unsigned char* lds, const Gemm g, const Sched& S, const Epi& E) {
    int tid_ = threadIdx.x; asm volatile("" : "+v"(tid_));
    const int tid = tid_, wid = __builtin_amdgcn_readfirstlane(tid >> 6), lane = tid & 63, wr = wid >> 2, wc = wid & 3, fr = lane & 15, fq = lane >> 4;
    int K_ = g.K; asm volatile("" : "+s"(K_)); const int K = K_, nt = K / BK;
    unsigned voffA[2], voffB[2];
#pragma unroll
    for (int i = 0; i < 2; ++i) { int R, C; stage_rc(tid * 16 + i * 8192, R, C); const int Rb = Epi::PERM ? ((R & ~31) + perm32(R & 31)) : R;
        voffA[i] = (unsigned)(R * g.lda + C) * 2u; voffB[i] = (unsigned)(Rb * g.ldb + C) * 2u; }
    const size_t kstep = (size_t)(BK * 2);
    const size_t hstepA = (size_t)HALF * g.lda * 2, hstepB = (size_t)HALF * g.ldb * 2;
    const size_t tstepA = 2 * hstepA, tstepB = 2 * hstepB;
    const unsigned ldsw = (unsigned)wid * 1024u;
    const int aoff = lds_byte(wr * 64 + fr, fq * 8), boff = lds_byte(wc * 32 + fr, fq * 8);
#define PG8_SA(b, h) (((b) * 2 + (h)) * HTB)
#define PG8_SB(b, h) ((4 + (b) * 2 + (h)) * HTB)
#define PG8_STAGE(bufoff, gbase, voff) do { _Pragma("unroll") for (int _i = 0; _i < 2; ++_i) \
        __builtin_amdgcn_global_load_lds((const unsigned*)((const char*)(gbase) + (voff)[_i]), (LAS unsigned*)(lds + (bufoff) + ldsw + _i * 8192), 16, 0, 0); } while (0)
#define PG8_LDA(dst, b, h) do { _Pragma("unroll") for (int m = 0; m < 4; ++m) _Pragma("unroll") for (int k = 0; k < 2; ++k) dst[m][k] = *(const LAS bf16x8*)(lds + PG8_SA(b, h) + aoff + m * 2048 + k * 1024); } while (0)
#define PG8_LDB(dst, b, h) do { _Pragma("unroll") for (int n = 0; n < 2; ++n) _Pragma("unroll") for (int k = 0; k < 2; ++k) dst[n][k] = *(const LAS bf16x8*)(lds + PG8_SB(b, h) + boff + n * 2048 + k * 1024); } while (0)
#define PG8_MMA(ai, bj, At, Bt) do { __builtin_amdgcn_s_setprio(1); _Pragma("unroll") for (int m = 0; m < 4; ++m) _Pragma("unroll") for (int n = 0; n < 2; ++n) _Pragma("unroll") for (int k = 0; k < 2; ++k) \
        acc[ai][bj][m][n] = __builtin_amdgcn_mfma_f32_16x16x32_bf16(Bt[n][k], At[m][k], acc[ai][bj][m][n], 0, 0, 0); __builtin_amdgcn_s_setprio(0); } while (0)
#define PG8_WAIT_V(n) asm volatile("s_waitcnt vmcnt(" #n ")" ::: "memory")
#define PG8_WAIT_L(n) asm volatile("s_waitcnt lgkmcnt(" #n ")" ::: "memory")
#define PG8_BAR __builtin_amdgcn_s_barrier()
#define PG8_SCHED __builtin_amdgcn_sched_barrier(0)
    Unit cur, nxt; int ui = 0;
    if (!S.next(0, cur)) return;
    f32x4 acc[2][2][4][2];
#pragma unroll
    for (int a = 0; a < 2; ++a)
#pragma unroll
        for (int b = 0; b < 2; ++b)
#pragma unroll
            for (int m = 0; m < 4; ++m)
#pragma unroll
                for (int n = 0; n < 2; ++n) acc[a][b][m][n] = (f32x4){0.f, 0.f, 0.f, 0.f};
    bf16x8 At[4][2], B0[2][2], B1[2][2];
    const char* cA = (const char*)g.A + (size_t)cur.pm * tstepA + (size_t)cur.kofs * 2; const char* cB = (const char*)g.Bt + (size_t)cur.pn * tstepB + (size_t)cur.kofs * 2;
    S.a_ready(cur);
    PG8_STAGE(PG8_SB(0, 0), cB, voffB); PG8_STAGE(PG8_SB(0, 1), cB + hstepB, voffB); PG8_STAGE(PG8_SA(0, 0), cA, voffA); PG8_STAGE(PG8_SA(0, 1), cA + hstepA, voffA);
    if (wr == 1) PG8_BAR;
    PG8_WAIT_V(2); PG8_BAR;
    PG8_STAGE(PG8_SB(1, 0), cB + kstep, voffB); PG8_STAGE(PG8_SA(1, 0), cA + kstep, voffA); PG8_STAGE(PG8_SB(1, 1), cB + hstepB + kstep, voffB);
    PG8_WAIT_V(6); PG8_BAR;
    for (;;) {
        const bool has_next = S.next(ui + 1, nxt);
        const char* nA = has_next ? (const char*)g.A + (size_t)nxt.pm * tstepA + (size_t)nxt.kofs * 2 : cA; const char* nB = has_next ? (const char*)g.Bt + (size_t)nxt.pn * tstepB + (size_t)nxt.kofs * 2 : cB;
        const int ntc = cur.nt ? cur.nt : nt;
#pragma clang loop unroll(disable)
        for (int t = 0; t < ntc; t += 2) {
            const bool last = (t == ntc - 2);
            const char* a1 = cA + (size_t)(t + 1) * kstep;
            const char* a2 = last ? nA : cA + (size_t)(t + 2) * kstep; const char* b2 = last ? nB : cB + (size_t)(t + 2) * kstep;
            const char* a3 = a2 + kstep; const char* b3 = b2 + kstep;
            if (last && has_next) S.a_ready(nxt);
            PG8_LDB(B0, 0, 0); PG8_LDB(B1, 0, 1); PG8_SCHED; PG8_LDA(At, 0, 0); PG8_STAGE(PG8_SA(1, 1), a1 + hstepA, voffA);
            PG8_WAIT_V(8); PG8_WAIT_L(0); PG8_BAR; PG8_MMA(0, 0, At, B0); PG8_MMA(0, 1, At, B1); PG8_BAR; PG8_SCHED;
            PG8_LDA(At, 0, 1); PG8_STAGE(PG8_SB(0, 0), b2, voffB); PG8_STAGE(PG8_SB(0, 1), b2 + hstepB, voffB); PG8_STAGE(PG8_SA(0, 0), a2, voffA);
            PG8_WAIT_V(8); PG8_WAIT_L(0); PG8_BAR; PG8_MMA(1, 0, At, B0); PG8_MMA(1, 1, At, B1); PG8_BAR; PG8_SCHED;
            PG8_LDB(B0, 1, 0); PG8_LDB(B1, 1, 1); PG8_SCHED; PG8_LDA(At, 1, 0); PG8_STAGE(PG8_SA(0, 1), a2 + hstepA, voffA);
            PG8_WAIT_V(8); PG8_WAIT_L(0); PG8_BAR; PG8_MMA(0, 0, At, B0); PG8_MMA(0, 1, At, B1); PG8_BAR; PG8_SCHED;
            PG8_LDA(At, 1, 1); PG8_STAGE(PG8_SB(1, 0), b3, voffB); PG8_STAGE(PG8_SB(1, 1), b3 + hstepB, voffB); PG8_STAGE(PG8_SA(1, 0), a3, voffA);
            PG8_WAIT_V(8); PG8_WAIT_L(0); PG8_BAR; PG8_MMA(1, 0, At, B0); PG8_MMA(1, 1, At, B1); PG8_BAR; PG8_SCHED;
        }
        if (wr == 0) PG8_BAR;
        E(acc, cur, wr, wc, fr, fq); S.done(cur);
        if (!has_next) break;
#pragma unroll
        for (int a = 0; a < 2; ++a)
#pragma unroll
            for (int b = 0; b < 2; ++b)
#pragma unroll
                for (int m = 0; m < 4; ++m)
#pragma unroll
                    for (int n = 0; n < 2; ++n) acc[a][b][m][n] = (f32x4){0.f, 0.f, 0.f, 0.f};
        cur = nxt; cA = nA; cB = nB; ++ui;
        if (wr == 1) PG8_BAR;
    }
    PG8_WAIT_V(0);
    PG8_BAR;
#undef PG8_SA
#undef PG8_SB
#undef PG8_STAGE
#undef PG8_LDA
#undef PG8_LDB
#undef PG8_MMA
#undef PG8_WAIT_V
#undef PG8_WAIT_L
#undef PG8_BAR
#undef PG8_SCHED
}

typedef const f32x4 (&AccRef)[2][2][4][2];

struct EpiSwiglu { static constexpr bool PERM = true; bf16_t* H;
    __device__ __forceinline__ void operator()(AccRef acc, const Unit& u, int wr, int wc, int fr, int fq) const {
        const int row0 = u.pm * 256 + wr * 64 + fr, col0 = u.pn * 128 + wc * 32 + 8 * fq;
#pragma unroll
        for (int ai = 0; ai < 2; ++ai)
#pragma unroll
            for (int m = 0; m < 4; ++m) { bf16_t* rowp = H + (size_t)(row0 + ai * 128 + m * 16) * FF + col0;
                f32x4 h0, h1;
#pragma unroll
                for (int e = 0; e < 4; ++e) { h0[e] = siluf_(acc[ai][0][m][0][e]) * acc[ai][1][m][0][e]; h1[e] = siluf_(acc[ai][0][m][1][e]) * acc[ai][1][m][1][e]; }
                *(u32x4*)rowp = pack8(h0, h1); }
    }
};
struct EpiResid { static constexpr bool PERM = true; const bf16_t* xsrc; bf16_t* tdst; float scale; int row_off; bf16_t* part;
    __device__ __forceinline__ void operator()(AccRef acc, const Unit& u, int wr, int wc, int fr, int fq) const {
        const int row0 = row_off + u.pm * 256 + wr * 64 + fr, col0 = u.pn * 256 + wc * 32 + 8 * fq;
        if (u.nt) {
#pragma unroll
            for (int ai = 0; ai < 2; ++ai)
#pragma unroll
                for (int m = 0; m < 4; ++m) { bf16_t* pp = part + ((size_t)u.g * MS + (row0 + ai * 128 + m * 16 - MP)) * DM + col0;
#pragma unroll
                    for (int bj = 0; bj < 2; ++bj) *(u32x4*)(pp + bj * 128) = pack8(acc[ai][bj][m][0], acc[ai][bj][m][1]); }
        } else {
#pragma unroll
            for (int ai = 0; ai < 2; ++ai)
#pragma unroll
                for (int m = 0; m < 4; ++m) { const size_t ro = (size_t)(row0 + ai * 128 + m * 16) * DM + col0;
#pragma unroll
                    for (int bj = 0; bj < 2; ++bj) { const u32x4 xw = *(const u32x4*)(xsrc + ro + bj * 128);
                        const f32x4 x0 = (f32x4){bflo(xw.x), bfhi(xw.x), bflo(xw.y), bfhi(xw.y)}, x1 = (f32x4){bflo(xw.z), bfhi(xw.z), bflo(xw.w), bfhi(xw.w)};
                        *(u32x4*)(tdst + ro + bj * 128) = pack8(x0 * ALPHA + acc[ai][bj][m][0] * scale, x1 * ALPHA + acc[ai][bj][m][1] * scale); } }
        }
    }
};
struct EpiZe { static constexpr bool PERM = true; bf16_t* ZP; bf16_t* UP; float* out;
    __device__ __forceinline__ void operator()(AccRef acc, const Unit& u, int wr, int wc, int fr, int fq) const {
        const int row0 = u.pm * 256 + wr * 64 + fr, col0 = u.pn * 256 + wc * 32 + 8 * fq;
#pragma unroll
        for (int ai = 0; ai < 2; ++ai)
#pragma unroll
            for (int m = 0; m < 4; ++m) { const int row = row0 + ai * 128 + m * 16;
#pragma unroll
                for (int bj = 0; bj < 2; ++bj) { const int col = col0 + bj * 128; const f32x4 v0 = acc[ai][bj][m][0], v1 = acc[ai][bj][m][1];
                    if (u.pn < 6) {
                        *(u32x4*)(ZP + (size_t)row * 1536 + col) = pack8(v0, v1);
                        float* op = nullptr;
                        if (row < MP) { const int t = row & (SEQ - 1); if (t >= SEQ - 15) op = out + O_POOLP + ((size_t)((row >> 14) * 15 + (t - (SEQ - 15))) * 1536 + col); }
                        else { const int rs = row - MP, t = rs & 63; if (t >= 49) op = out + O_POOLS + ((size_t)((rs >> 6) * 15 + (t - 49)) * 1536 + col); }
                        if (op) { *(f32x4*)op = v0; *(f32x4*)(op + 4) = v1; }
                    } else {
                        const int cs = col - 1536, g = cs >> 4, c8 = cs & 15;
                        const int chunkrow = row < MP ? (row >> 6) : 512 + ((row - MP) >> 6), i = row & 63;
                        *(u32x4*)(UP + ((size_t)g * 768 + chunkrow) * 1152 + (63 - i) * 16 + c8) = pack8(v0, v1);
                    } } }
    }
};
struct EpiS1 { static constexpr bool PERM = false; float* S1;
    __device__ __forceinline__ void operator()(AccRef acc, const Unit& u, int wr, int wc, int fr, int fq) const {
        const int row0 = u.lm * 256 + wr * 64 + fr, col0 = wc * 32 + 4 * fq;
#pragma unroll
        for (int ai = 0; ai < 2; ++ai)
#pragma unroll
            for (int m = 0; m < 4; ++m) { float* rp = S1 + ((size_t)u.g * 768 + row0 + ai * 128 + m * 16) * 128 + col0;
#pragma unroll
                for (int n = 0; n < 2; ++n) *(f32x4*)(rp + n * 16) = acc[ai][0][m][n]; }
    }
};
struct EpiPool { static constexpr bool PERM = true; bf16_t* MIX; const float* pscale;
    __device__ __forceinline__ void operator()(AccRef acc, const Unit& u, int wr, int wc, int fr, int fq) const {
        const int row0 = u.lm * 256 + wr * 64 + fr, col0 = u.ln * 256 + wc * 32 + 8 * fq;
#pragma unroll
        for (int bj = 0; bj < 2; ++bj) { const int col = col0 + bj * 128;
            if (col < 384) { const f32x4 s0 = *(const f32x4*)(pscale + u.g * 384 + col), s1 = *(const f32x4*)(pscale + u.g * 384 + col + 4);
#pragma unroll
                for (int ai = 0; ai < 2; ++ai)
#pragma unroll
                    for (int m = 0; m < 4; ++m) *(u32x4*)(MIX + (size_t)(row0 + ai * 128 + m * 16) * DM + u.g * 384 + col) = pack8(acc[ai][bj][m][0] * s0, acc[ai][bj][m][1] * s1); } }
    }
};
struct EpiS2 { static constexpr bool PERM = true; bf16_t* GACT;
    __device__ __forceinline__ void operator()(AccRef acc, const Unit& u, int wr, int wc, int fr, int fq) const {
        const int row0 = u.lm * 256 + wr * 64 + fr, col0 = u.ln * 256 + wc * 32 + 8 * fq;
#pragma unroll
        for (int ai = 0; ai < 2; ++ai)
#pragma unroll
            for (int m = 0; m < 4; ++m) { const int rl = row0 + ai * 128 + m * 16;
                if (rl < 544) {
#pragma unroll
                    for (int bj = 0; bj < 2; ++bj) { const int col = col0 + bj * 128, j = col >> 4, c8 = col & 15;
                        const int tok = rl < 512 ? rl * 64 + j : MP + (rl - 512) * 64 + j;
                        f32x4 a = acc[ai][bj][m][0], b = acc[ai][bj][m][1];
#pragma unroll
                        for (int e = 0; e < 4; ++e) { a[e] = gelu_tanh(a[e]); b[e] = gelu_tanh(b[e]); }
                        *(u32x4*)(GACT + (size_t)tok * 512 + u.g * 16 + c8) = pack8(a, b); } } }
    }
};
struct EpiGlu { static constexpr bool PERM = true; const bf16_t* GACT; const float* bglu; bf16_t* MIX;
    __device__ __forceinline__ void operator()(AccRef acc, const Unit& u, int wr, int wc, int fr, int fq) const {
        const int row0 = u.pm * 256 + wr * 64 + fr, col0 = u.pn * 256 + wc * 32 + 8 * fq;
#pragma unroll
        for (int bj = 0; bj < 2; ++bj) { const int col = col0 + bj * 128; const f32x4 b0 = *(const f32x4*)(bglu + col), b1 = *(const f32x4*)(bglu + col + 4);
#pragma unroll
            for (int ai = 0; ai < 2; ++ai)
#pragma unroll
                for (int m = 0; m < 4; ++m) { const int row = row0 + ai * 128 + m * 16; const u32x4 gw = *(const u32x4*)(GACT + (size_t)row * 512 + col);
                    const f32x4 g0 = (f32x4){bflo(gw.x), bfhi(gw.x), bflo(gw.y), bfhi(gw.y)}, g1 = (f32x4){bflo(gw.z), bfhi(gw.z), bflo(gw.w), bfhi(gw.w)};
                    f32x4 o0, o1;
#pragma unroll
                    for (int e = 0; e < 4; ++e) { o0[e] = g0[e] * sigmoidf_(acc[ai][bj][m][0][e] + b0[e]); o1[e] = g1[e] * sigmoidf_(acc[ai][bj][m][1][e] + b1[e]); }
                    *(u32x4*)(MIX + (size_t)row * DM + 1536 + col) = pack8(o0, o1); } }
    }
};
struct EpiZo { static constexpr bool PERM = true; bf16_t* ZQ; bf16_t* ZC; float* ZK; bf16_t* UB; bf16_t* VPRE;
    __device__ __forceinline__ void operator()(AccRef acc, const Unit& u, int wr, int wc, int fr, int fq) const {
        const int row0 = u.pm * 256 + wr * 64 + fr, cl0 = wc * 32 + 8 * fq;
#pragma unroll
        for (int ai = 0; ai < 2; ++ai)
#pragma unroll
            for (int m = 0; m < 4; ++m) { const size_t row = (size_t)(row0 + ai * 128 + m * 16);
#pragma unroll
                for (int bj = 0; bj < 2; ++bj) { const int cl = cl0 + bj * 128; const f32x4 v0 = acc[ai][bj][m][0], v1 = acc[ai][bj][m][1];
                    if (u.pn < 2) *(u32x4*)(ZQ + row * 512 + u.pn * 256 + cl) = pack8(v0, v1);
                    else if (u.pn == 2) *(u32x4*)(ZC + row * 256 + cl) = pack8(v0, v1);
                    else if (u.pn < 7) *(u32x4*)(UB + row * 1024 + (u.pn - 3) * 256 + cl) = pack8(v0, v1);
                    else if (u.pn < 11) *(u32x4*)(VPRE + row * 1024 + (u.pn - 7) * 256 + cl) = pack8(v0, v1);
                    else if (cl < 32) { float* p = ZK + row * 32 + cl; *(f32x4*)p = v0; *(f32x4*)(p + 4) = v1; } } }
    }
};
struct EpiQ { static constexpr bool PERM = true; bf16_t* QP; bf16_t* QS; const float* rope;
    __device__ __forceinline__ void operator()(AccRef acc, const Unit& u, int wr, int wc, int fr, int fq) const {
        const int row0 = u.pm * 256 + wr * 64 + fr;
#pragma unroll
        for (int ai = 0; ai < 2; ++ai)
#pragma unroll
            for (int m = 0; m < 4; ++m) { const int row = row0 + ai * 128 + m * 16;
                if (u.pn < 4) {
#pragma unroll
                    for (int bj = 0; bj < 2; ++bj) { const int col = u.pn * 256 + bj * 128 + wc * 32 + 8 * fq, h = col >> 6, d = col & 63;
                        *(u32x4*)(QP + (size_t)row * 1536 + h * 96 + d) = pack8(acc[ai][bj][m][0] * C2, acc[ai][bj][m][1] * C2); }
                } else {
                    const int pos = row < MP ? (row & (SEQ - 1)) : 4096 + ((row - MP) & 63);
                    const f32x4 cs = *(const f32x4*)(rope + (size_t)pos * 32 + 4 * fq), sn = *(const f32x4*)(rope + (size_t)pos * 32 + 16 + 4 * fq);
#pragma unroll
                    for (int bj = 0; bj < 2; ++bj) { const int h = (u.pn - 4) * 8 + bj * 4 + wc; const f32x4 x1 = acc[ai][bj][m][0], x2 = acc[ai][bj][m][1];
                        const f32x4 o1 = (x1 * cs - x2 * sn) * C2, o2 = (x2 * cs + x1 * sn) * C2;
                        bf16_t* p = row < MP ? QP + (size_t)row * 1536 + h * 96 + 64 + 4 * fq : QS + (size_t)(row - MP) * 4608 + h * 288 + 256 + 4 * fq;
                        u32x2 w1, w2; w1.x = pk2(o1[0], o1[1]); w1.y = pk2(o1[2], o1[3]); w2.x = pk2(o2[0], o2[1]); w2.y = pk2(o2[2], o2[3]);
                        *(u32x2*)p = w1; *(u32x2*)(p + 16) = w2; }
                } }
    }
};
struct EpiQlat { static constexpr bool PERM = true; bf16_t* QS;
    __device__ __forceinline__ void operator()(AccRef acc, const Unit& u, int wr, int wc, int fr, int fq) const {
        const int row0 = u.lm * 256 + wr * 64 + fr;
#pragma unroll
        for (int ai = 0; ai < 2; ++ai)
#pragma unroll
            for (int m = 0; m < 4; ++m)
#pragma unroll
                for (int bj = 0; bj < 2; ++bj) { const int col = u.pn * 256 + bj * 128 + wc * 32 + 8 * fq, h = col >> 8, r = col & 255;
                    *(u32x4*)(QS + (size_t)(row0 + ai * 128 + m * 16) * 4608 + h * 288 + r) = pack8(acc[ai][bj][m][0] * C2, acc[ai][bj][m][1] * C2); }
    }
};
struct EpiKV { static constexpr bool PERM = true; bf16_t* KP; bf16_t* VP;
    __device__ __forceinline__ void operator()(AccRef acc, const Unit& u, int wr, int wc, int fr, int fq) const {
        const int row0 = u.pm * 256 + wr * 64 + fr;
#pragma unroll
        for (int ai = 0; ai < 2; ++ai)
#pragma unroll
            for (int m = 0; m < 4; ++m) { const size_t row = (size_t)(row0 + ai * 128 + m * 16);
#pragma unroll
                for (int bj = 0; bj < 2; ++bj) { const int col = u.pn * 256 + bj * 128 + wc * 32 + 8 * fq; const u32x4 w = pack8(acc[ai][bj][m][0], acc[ai][bj][m][1]);
                    if (u.pn < 4) *(u32x4*)(KP + row * 1024 + col) = w;        else *(u32x4*)(VP + row * 1024 + (col - 1024)) = w; } }
    }
};
struct EpiPlain { static constexpr bool PERM = true; bf16_t* O; int ldc;
    __device__ __forceinline__ void operator()(AccRef acc, const Unit& u, int wr, int wc, int fr, int fq) const {
        const int row0 = u.pm * 256 + wr * 64 + fr;
#pragma unroll
        for (int ai = 0; ai < 2; ++ai)
#pragma unroll
            for (int m = 0; m < 4; ++m)
#pragma unroll
                for (int bj = 0; bj < 2; ++bj) { const int col = u.pn * 256 + bj * 128 + wc * 32 + 8 * fq;
                    *(u32x4*)(O + (size_t)(row0 + ai * 128 + m * 16) * ldc + col) = pack8(acc[ai][bj][m][0], acc[ai][bj][m][1]); }
    }
};
}

namespace att {
constexpr float THR = 8.f;
__device__ __forceinline__ int crow(int r, int hi) { return (r & 3) + 8 * (r >> 2) + 4 * hi; }
__device__ __forceinline__ unsigned cvtpk(float lo, float hi) { unsigned r; asm volatile("v_cvt_pk_bf16_f32 %0, %1, %2" : "=v"(r) : "v"(lo), "v"(hi)); return r; }
template <int NVB> __device__ __forceinline__ int v_st(int k, int c) { const int kk = k;        return ((kk >> 3) * NVB + (c >> 5)) * 512 + ((kk & 7) * 32 + (c & 31)) * 2; }
__device__ __forceinline__ int v_rd_base(int lane) { return ((lane & 3) << 3) | (((lane >> 2) & 3) << 6) | (((lane >> 4) & 1) << 5) | (((lane >> 5) & 1) << 8); }
template <int OFF> __device__ __forceinline__ s16x4 tr_read(int vb) { s16x4 r; asm volatile("ds_read_b64_tr_b16 %0, %1 offset:%2" : "=&v"(r) : "v"(vb), "i"(OFF) : "memory"); return r; }
struct VFrag { s16x4 l0, h0, l1, h1, l2, h2, l3, h3; };
template <int NVB, int D0> __device__ __forceinline__ void pv_load(VFrag& f, int vb) {
    constexpr int KS = 2 * NVB * 512, HF = NVB * 512;
    f.l0 = tr_read<D0 * 512 + 0 * KS>(vb); f.h0 = tr_read<D0 * 512 + 0 * KS + HF>(vb); f.l1 = tr_read<D0 * 512 + 1 * KS>(vb); f.h1 = tr_read<D0 * 512 + 1 * KS + HF>(vb);
    f.l2 = tr_read<D0 * 512 + 2 * KS>(vb); f.h2 = tr_read<D0 * 512 + 2 * KS + HF>(vb); f.l3 = tr_read<D0 * 512 + 3 * KS>(vb); f.h3 = tr_read<D0 * 512 + 3 * KS + HF>(vb);
}
template <int PENDING> __device__ __forceinline__ void pv_mma(f32x16& od, const VFrag& f, bf16x8 pa0, bf16x8 pa1, bf16x8 pa2, bf16x8 pa3) {
    if constexpr (PENDING == 8) asm volatile("s_waitcnt lgkmcnt(8)" ::: "memory"); else asm volatile("s_waitcnt lgkmcnt(0)" ::: "memory"); __builtin_amdgcn_sched_barrier(0);
#define PK(L, H) (bf16x8){L[0], L[1], L[2], L[3], H[0], H[1], H[2], H[3]}
    od = __builtin_amdgcn_mfma_f32_32x32x16_bf16(PK(f.l0, f.h0), pa0, od, 0, 0, 0);
    od = __builtin_amdgcn_mfma_f32_32x32x16_bf16(PK(f.l1, f.h1), pa1, od, 0, 0, 0);
    od = __builtin_amdgcn_mfma_f32_32x32x16_bf16(PK(f.l2, f.h2), pa2, od, 0, 0, 0);
    od = __builtin_amdgcn_mfma_f32_32x32x16_bf16(PK(f.l3, f.h3), pa3, od, 0, 0, 0);
#undef PK
}
template <int NVB, int D0> __device__ __forceinline__ void pv_one(f32x16& od, int vb, bf16x8 pa0, bf16x8 pa1, bf16x8 pa2, bf16x8 pa3) { VFrag f; pv_load<NVB, D0>(f, vb); pv_mma<0>(od, f, pa0, pa1, pa2, pa3); }
#define PK4(P, BASE, OUT) do { u32x4 w = {cvtpk(P[BASE + 0], P[BASE + 1]), cvtpk(P[BASE + 2], P[BASE + 3]), cvtpk(P[BASE + 4], P[BASE + 5]), cvtpk(P[BASE + 6], P[BASE + 7])}; OUT = __builtin_bit_cast(bf16x8, w); } while (0)
__device__ __forceinline__ bool softmax_tile(f32x16& p0, f32x16& p1, float& m_reg, float& l_reg, float& alpha, bf16x8& pa0, bf16x8& pa1, bf16x8& pa2, bf16x8& pa3) {
    float pmax = p0[0];
#pragma unroll
    for (int r = 1; r < 16; ++r) pmax = fmaxf(pmax, p0[r]);
#pragma unroll
    for (int r = 0; r < 16; ++r) pmax = fmaxf(pmax, p1[r]);
    { float lo_, hi_; half_swap(pmax, lo_, hi_); pmax = fmaxf(lo_, hi_); }
    float mn;
    if (__all(pmax - m_reg <= THR)) { mn = m_reg; alpha = 1.f; }
    else { mn = fmaxf(m_reg, pmax); alpha = ex2(m_reg - mn); m_reg = mn; }
    float ps = 0.f;
#pragma unroll
    for (int r = 0; r < 16; ++r) { p0[r] = ex2(p0[r] - mn); ps += p0[r]; }
#pragma unroll
    for (int r = 0; r < 16; ++r) { p1[r] = ex2(p1[r] - mn); ps += p1[r]; }
    { float lo_, hi_; half_swap(ps, lo_, hi_); ps = lo_ + hi_; }
    l_reg = l_reg * alpha + ps;
    PK4(p0, 0, pa0); PK4(p0, 8, pa1); PK4(p1, 0, pa2); PK4(p1, 8, pa3);
    return __any(alpha < 1.f);
}
__device__ __forceinline__ bool softmax_tile_rel(f32x16& p0, f32x16& p1, float& m_reg, float& l_reg, float& alpha, f32x16& negm, bool first, bf16x8& pa0, bf16x8& pa1, bf16x8& pa2, bf16x8& pa3) {
    f32x16 e0, e1; float ps = 0.f;
#pragma unroll
    for (int r = 0; r < 16; ++r) { e0[r] = ex2(p0[r]); ps += e0[r]; }
#pragma unroll
    for (int r = 0; r < 16; ++r) { e1[r] = ex2(p1[r]); ps += e1[r]; }
    const bool upd = first || !__all(ps <= 256.f);
    alpha = 1.f;
    if (upd) {
        float pmax = p0[0];
#pragma unroll
        for (int r = 1; r < 16; ++r) pmax = fmaxf(pmax, p0[r]);
#pragma unroll
        for (int r = 0; r < 16; ++r) pmax = fmaxf(pmax, p1[r]);
        float lo_, hi_; half_swap(pmax, lo_, hi_); pmax = fmaxf(lo_, hi_); const float d = first ? pmax : fmaxf(pmax, 0.f); alpha = first ? 1.f : ex2(-d); m_reg += d;
        ps = 0.f;
#pragma unroll
        for (int r = 0; r < 16; ++r) { e0[r] = ex2(p0[r] - d); ps += e0[r]; }
#pragma unroll
        for (int r = 0; r < 16; ++r) { e1[r] = ex2(p1[r] - d); ps += e1[r]; }
#pragma unroll
        for (int r = 0; r < 16; ++r) negm[r] = -m_reg; }
    l_reg = l_reg * alpha + ps;
    PK4(e0, 0, pa0); PK4(e0, 8, pa1); PK4(e1, 0, pa2); PK4(e1, 8, pa3);
    return upd && !first;
}
#undef PK4

template <bool SAMPLE>
__device__ __forceinline__ void attn_unit(char* lds, const bf16_t* __restrict__ Qrow  , const bf16_t* __restrict__ Kg, const bf16_t* __restrict__ Vg, int NT, int jmax,
                                          bf16_t* __restrict__ Orow0  , int ldo, int vcol0  ) {
    constexpr int NKS = SAMPLE ? 18 : 6, NCB = SAMPLE ? 4 : 2, NVB = SAMPLE ? 8 : 2, KROWB = SAMPLE ? 592 : 208, KBYTES = 64 * KROWB, VBYTES = 64 * NVB * 64, BUF = KBYTES + VBYTES;
    constexpr int LDK = SAMPLE ? 288 : 1536, LDV = SAMPLE ? 288 : 1024, KCH = SAMPLE ? 36 : 12, NKC = 64 * KCH, NSTG = SAMPLE ? 5 : 2;
    int tid_ = threadIdx.x; asm volatile("" : "+v"(tid_));
    const int tid = tid_, wid = tid >> 6, lane = tid & 63, r32 = lane & 31, hi = lane >> 5;
    float* wsf = (float*)(lds + 2 * BUF) + wid * 64; float* li_l = wsf; float* al_l = wsf + 32;
    bf16x8 qr[NKS];
#pragma unroll
    for (int d0 = 0; d0 < NKS; ++d0) qr[d0] = *(const bf16x8*)(Qrow + d0 * 16);
    int srow[NSTG], sch[NSTG];
#pragma unroll
    for (int k = 0; k < NSTG; ++k) { const int idx = tid + 512 * k; srow[k] = idx / KCH; sch[k] = idx % KCH; }
    bf16x8 sk[NSTG]; bf16x8 sv;
#define SLOAD(t) do { _Pragma("unroll") for (int k = 0; k < NSTG; ++k) if (tid + 512 * k < NKC) sk[k] = *(const bf16x8*)(Kg + (size_t)((t) * 64 + srow[k]) * LDK + sch[k] * 8); \
        if (!SAMPLE) sv = *(const bf16x8*)(Vg + (size_t)((t) * 64 + (tid >> 3)) * LDV + (tid & 7) * 8); } while (0)
#define SWRITE(b) do { char* kb_ = lds + (b) * BUF; _Pragma("unroll") for (int k = 0; k < NSTG; ++k) if (tid + 512 * k < NKC) { *(bf16x8*)(kb_ + srow[k] * KROWB + sch[k] * 16) = sk[k]; \
            if (SAMPLE && sch[k] < 32) *(bf16x8*)(kb_ + KBYTES + v_st<NVB>(srow[k], sch[k] * 8)) = sk[k]; } \
        if (!SAMPLE) *(bf16x8*)(kb_ + KBYTES + v_st<NVB>(tid >> 3, (tid & 7) * 8)) = sv; } while (0)
    float m_reg = SAMPLE ? -1e30f : 0.f, l_reg = 0.f; f32x16 o[NCB]; f32x16 negm = f32x16{};
#pragma unroll
    for (int d = 0; d < NCB; ++d) o[d] = f32x16{};
    const int vb0 = (int)(unsigned)(uintptr_t)lds + KBYTES + v_rd_base(lane) + vcol0 * 512;
    SLOAD(0); SWRITE(0); if (NT > 1) SLOAD(1);
    __syncthreads();
    for (int j = 0; j < NT; ++j) {
        const int b = j & 1;
        if (j <= jmax) {
            const char* Ks = lds + b * BUF;
            f32x16 p0 = f32x16{}, p1 = f32x16{};
#pragma unroll
            for (int d0 = 0; d0 < NKS; ++d0) { const int cb = (d0 * 16 + hi * 8) * 2;
                const bf16x8 k0 = *(const bf16x8*)(Ks + r32 * KROWB + cb), k1 = *(const bf16x8*)(Ks + (32 + r32) * KROWB + cb);
                if (!SAMPLE && d0 == 0) { p0 = __builtin_amdgcn_mfma_f32_32x32x16_bf16(k0, qr[0], negm, 0, 0, 0); p1 = __builtin_amdgcn_mfma_f32_32x32x16_bf16(k1, qr[0], negm, 0, 0, 0); }
                else { p0 = __builtin_amdgcn_mfma_f32_32x32x16_bf16(k0, qr[d0], p0, 0, 0, 0); p1 = __builtin_amdgcn_mfma_f32_32x32x16_bf16(k1, qr[d0], p1, 0, 0, 0); } }
            float alpha; bf16x8 pa0, pa1, pa2, pa3;
            bool resc;
            if constexpr (SAMPLE) resc = softmax_tile(p0, p1, m_reg, l_reg, alpha, pa0, pa1, pa2, pa3);
            else resc = softmax_tile_rel(p0, p1, m_reg, l_reg, alpha, negm, j == 0, pa0, pa1, pa2, pa3);
            if (resc) {
#pragma unroll
                for (int d = 0; d < NCB; ++d)
#pragma unroll
                    for (int r = 0; r < 16; ++r) o[d][r] *= alpha; }
            const int vb = vb0 + b * BUF;
            pv_one<NVB, 0>(o[0], vb, pa0, pa1, pa2, pa3); pv_one<NVB, 1>(o[1], vb, pa0, pa1, pa2, pa3);
            if constexpr (NCB == 4) { pv_one<NVB, 2>(o[2], vb, pa0, pa1, pa2, pa3); pv_one<NVB, 3>(o[3], vb, pa0, pa1, pa2, pa3); }
        }
        if (j + 1 < NT) SWRITE(b ^ 1);
        if (j + 2 < NT) SLOAD(j + 2);
        __syncthreads();
    }
    if constexpr (!SAMPLE) { float lo_, hi_; half_swap(l_reg, lo_, hi_); l_reg = lo_ + hi_; }
    { const float rl = __builtin_amdgcn_rcpf(l_reg); bf16_t* orow = Orow0 + (size_t)r32 * ldo + 4 * hi;
#pragma unroll
      for (int d0 = 0; d0 < NCB; ++d0)
#pragma unroll
          for (int i = 0; i < 4; ++i) { u32x2 w; w.x = pk2(o[d0][4 * i] * rl, o[d0][4 * i + 1] * rl); w.y = pk2(o[d0][4 * i + 2] * rl, o[d0][4 * i + 3] * rl); *(u32x2*)(orow + d0 * 32 + 8 * i) = w; } }
    __syncthreads();
#undef SLOAD
#undef SWRITE
}

__device__ __forceinline__ void attn_unit_p2(char* lds, const bf16_t* __restrict__ Qrow, const bf16_t* __restrict__ Kg, const bf16_t* __restrict__ Kpe  , const bf16_t* __restrict__ Vg, int NT, int jmax, bf16_t* __restrict__ Orow0, int ldo) {
    constexpr int NKS = 6, NVB = 2, KROWB = 208, KBYTES = 64 * KROWB, VBYTES = 64 * NVB * 64, TB = KBYTES + VBYTES, BUF = 3 * TB, LDK = 1024, LDV = 1024, KCH = 12, NKC = 64 * KCH;
    int tid_ = threadIdx.x; asm volatile("" : "+v"(tid_));
    const int tid = tid_, lane = tid & 63, r32 = lane & 31, hi = lane >> 5;
    bf16x8 qr[NKS];
#pragma unroll
    for (int d0 = 0; d0 < NKS; ++d0) qr[d0] = *(const bf16x8*)(Qrow + d0 * 16);
    const int sr0 = tid / KCH, sc0 = tid % KCH, sr1 = (tid + 512) / KCH, sc1 = (tid + 512) % KCH; const bool two = tid + 512 < NKC;
    const bf16_t* kp0 = sc0 < 8 ? Kg + (size_t)sr0 * LDK + sc0 * 8 : Kpe + (size_t)sr0 * 32 + (sc0 - 8) * 8; const int ks0 = sc0 < 8 ? 64 * LDK : 64 * 32;
    const bf16_t* kp1 = sc1 < 8 ? Kg + (size_t)sr1 * LDK + sc1 * 8 : Kpe + (size_t)sr1 * 32 + (sc1 - 8) * 8; const int ks1 = sc1 < 8 ? 64 * LDK : 64 * 32;
    bf16x8 ka0, ka1 = bf16x8{}, va, kb0, kb1 = bf16x8{}, vb_, kc0, kc1 = bf16x8{}, vc;
#define SLOAD1(t, K0, K1, V_) do { const int t_ = (t) < NT ? (t) : NT - 1; K0 = *(const bf16x8*)(kp0 + (size_t)t_ * ks0); if (two) K1 = *(const bf16x8*)(kp1 + (size_t)t_ * ks1); \
        V_ = *(const bf16x8*)(Vg + (size_t)(t_ * 64 + (tid >> 3)) * LDV + (tid & 7) * 8); } while (0)
#define SWRITE1(base_, K0, K1, V_) do { char* kb_ = (base_); *(bf16x8*)(kb_ + sr0 * KROWB + sc0 * 16) = K0; if (two) *(bf16x8*)(kb_ + sr1 * KROWB + sc1 * 16) = K1; \
        *(bf16x8*)(kb_ + KBYTES + v_st<NVB>(tid >> 3, (tid & 7) * 8)) = V_; } while (0)
#define SLOAD3(pr) do { SLOAD1(3 * (pr), ka0, ka1, va); SLOAD1(3 * (pr) + 1, kb0, kb1, vb_); SLOAD1(3 * (pr) + 2, kc0, kc1, vc); } while (0)
#define SWRITE3(st_) do { SWRITE1(lds + (st_) * BUF, ka0, ka1, va); SWRITE1(lds + (st_) * BUF + TB, kb0, kb1, vb_); SWRITE1(lds + (st_) * BUF + 2 * TB, kc0, kc1, vc); } while (0)
    float m_reg = 0.f, l_reg = 0.f; f32x16 o0 = f32x16{}, o1 = f32x16{}, negm = f32x16{};
    const int vrd = (int)(unsigned)(uintptr_t)lds + KBYTES + v_rd_base(lane);
#define KPRE(off_, A_, B_) do { const char* Ks_ = lds + (off_) + hi * 16; A_ = *(const bf16x8*)(Ks_ + r32 * KROWB); B_ = *(const bf16x8*)(Ks_ + (32 + r32) * KROWB); } while (0)
#define TILE_QS(off_, first_, A_, B_) do { const char* Ks = lds + (off_); f32x16 p0, p1; \
        p0 = __builtin_amdgcn_mfma_f32_32x32x16_bf16(A_, qr[0], negm, 0, 0, 0); p1 = __builtin_amdgcn_mfma_f32_32x32x16_bf16(B_, qr[0], negm, 0, 0, 0); \
        _Pragma("unroll") for (int d0 = 1; d0 < NKS; ++d0) { const int cb = (d0 * 16 + hi * 8) * 2; \
            const bf16x8 k0 = *(const bf16x8*)(Ks + r32 * KROWB + cb), k1 = *(const bf16x8*)(Ks + (32 + r32) * KROWB + cb); \
            p0 = __builtin_amdgcn_mfma_f32_32x32x16_bf16(k0, qr[d0], p0, 0, 0, 0); p1 = __builtin_amdgcn_mfma_f32_32x32x16_bf16(k1, qr[d0], p1, 0, 0, 0); } \
        pv_load<NVB, 0>(vf0, vrd + (off_)); \
        float alpha; const bool resc = softmax_tile_rel(p0, p1, m_reg, l_reg, alpha, negm, (first_), pa0, pa1, pa2, pa3); \
        if (resc) { _Pragma("unroll") for (int r = 0; r < 16; ++r) { o0[r] *= alpha; o1[r] *= alpha; } } } while (0)
#define TILE_PV(off_) do { VFrag vf1; pv_load<NVB, 1>(vf1, vrd + (off_)); pv_mma<8>(o0, vf0, pa0, pa1, pa2, pa3); pv_mma<0>(o1, vf1, pa0, pa1, pa2, pa3); } while (0)
    const int NP = (NT + 2) / 3;
    SLOAD3(0); SWRITE3(0); if (NP > 1) SLOAD3(1);
    __syncthreads();
    for (int jj = 0; jj < NP; ++jj) {
        const int so = (jj & 1) * BUF;
        if (3 * jj <= jmax) { bf16x8 fa, fb, pa0, pa1, pa2, pa3; VFrag vf0;
            KPRE(so, fa, fb); TILE_QS(so, jj == 0, fa, fb);
            if (3 * jj + 1 <= jmax) KPRE(so + TB, fa, fb);
            TILE_PV(so);
            if (3 * jj + 1 <= jmax) { TILE_QS(so + TB, false, fa, fb);
                if (3 * jj + 2 <= jmax) KPRE(so + 2 * TB, fa, fb);
                TILE_PV(so + TB);
                if (3 * jj + 2 <= jmax) { TILE_QS(so + 2 * TB, false, fa, fb); TILE_PV(so + 2 * TB); } } }
        if (jj + 1 < NP) SWRITE3((jj & 1) ^ 1);
        if (jj + 2 < NP) SLOAD3(jj + 2);
        __syncthreads();
    }
#undef SLOAD1
#undef SWRITE1
#undef SLOAD3
#undef SWRITE3
#undef KPRE
#undef TILE_QS
#undef TILE_PV
    { float lo_, hi_; half_swap(l_reg, lo_, hi_); l_reg = lo_ + hi_; }
    { const float rl = __builtin_amdgcn_rcpf(l_reg); bf16_t* orow = Orow0 + (size_t)r32 * ldo + 4 * hi;
#pragma unroll
      for (int i = 0; i < 4; ++i) { u32x2 w0, w1; w0.x = pk2(o0[4 * i] * rl, o0[4 * i + 1] * rl); w0.y = pk2(o0[4 * i + 2] * rl, o0[4 * i + 3] * rl); w1.x = pk2(o1[4 * i] * rl, o1[4 * i + 1] * rl); w1.y = pk2(o1[4 * i + 2] * rl, o1[4 * i + 3] * rl);
          *(u32x2*)(orow + 8 * i) = w0; *(u32x2*)(orow + 32 + 8 * i) = w1; } }
    __syncthreads();
}
}

#define XB_TMO      128
#define XB_XCNT(j)  (256  + 64 * (j))
#define XB_XSUB(j)  (1280 + 64 * (j))
#define XB_XGEN(j)  (2304 + 64 * (j))
#define XB_TOP      3328
#define XB_TOPGEN   3392
#define XCD_BAR_WORDS 3456
#define XB_SPIN_CAP (1u << 22)
__device__ __forceinline__ unsigned xb_ld(unsigned* p)              { return __hip_atomic_load(p, __ATOMIC_RELAXED, __HIP_MEMORY_SCOPE_AGENT); }
__device__ __forceinline__ unsigned xb_add(unsigned* p, unsigned v) { return __hip_atomic_fetch_add(p, v, __ATOMIC_RELAXED, __HIP_MEMORY_SCOPE_AGENT); }
__device__ __forceinline__ unsigned xb_xcc_id() { return (unsigned)__builtin_amdgcn_s_getreg((3 << 11) | 20) & 0xFu; }
#define XB_SPIN(cond, bar) do { unsigned _sp = 0; while (cond) { __builtin_amdgcn_s_sleep(1); \
    if ((++_sp & 255u) == 0u) { if (xb_ld(&(bar)[XB_TMO])) break; if (_sp > XB_SPIN_CAP) { atomicAdd(&(bar)[XB_TMO], 1u); break; } } } } while (0)
struct XcdBarrier { unsigned* bar; unsigned x; volatile LAS unsigned* st; };
__device__ __forceinline__ XcdBarrier xcd_barrier_post(unsigned* bar, volatile LAS unsigned* st) {
    XcdBarrier b; b.bar = bar; b.x = xb_xcc_id(); b.st = st;
    if (threadIdx.x == 0) (void)xb_add(&bar[XB_XCNT(b.x)], 1u);
    return b;
}
__device__ __forceinline__ void xcd_barrier_complete(unsigned* bar, unsigned x, unsigned& nloc, unsigned& nx) {
    const unsigned G = gridDim.x * gridDim.y * gridDim.z;
    unsigned sum, cnt, mine, sp = 0u;
    for (;;) {
        sum = 0u; cnt = 0u; mine = 0u;
#pragma unroll
        for (unsigned j = 0; j < 16; ++j) { const unsigned c = xb_ld(&bar[XB_XCNT(j)]); sum += c; cnt += (c > 0u) ? 1u : 0u; mine = (j == x) ? c : mine; }
        if (sum == G) break;
        __builtin_amdgcn_s_sleep(1);
        if ((++sp & 255u) == 0u) { if (xb_ld(&bar[XB_TMO])) break; if (sp > XB_SPIN_CAP) { atomicAdd(&bar[XB_TMO], 1u); break; } }
    }
    nloc = mine > 0u ? mine : 1u; nx = cnt > 0u ? cnt : 1u;
}
__device__ __forceinline__ void xcd_barrier(const XcdBarrier& b) {
    asm volatile("s_waitcnt vmcnt(0)" ::: "memory");
    __syncthreads();
    if (threadIdx.x == 0) {
        unsigned* bar = b.bar;
        __builtin_amdgcn_s_waitcnt(0);
        unsigned nloc = b.st[0], nx = b.st[1];
        if (nloc == 0u) { xcd_barrier_complete(bar, b.x, nloc, nx); b.st[0] = nloc; b.st[1] = nx; }
        const unsigned old = xb_add(&bar[XB_XSUB(b.x)], 1u);
        const unsigned gen = old / nloc;
        if (old + 1u == (gen + 1u) * nloc) {
            __builtin_amdgcn_fence(__ATOMIC_RELEASE, "agent");
            asm volatile("s_waitcnt vmcnt(0)" ::: "memory");
            const unsigned og = xb_add(&bar[XB_TOP], 1u);
            const unsigned tg = og / nx;
            if (og + 1u == (tg + 1u) * nx) xb_add(&bar[XB_TOPGEN], 1u);
            else XB_SPIN(xb_ld(&bar[XB_TOPGEN]) == tg, bar);
            __builtin_amdgcn_fence(__ATOMIC_ACQUIRE, "agent");
            xb_add(&bar[XB_XGEN(b.x)], 1u);
            asm volatile("s_waitcnt vmcnt(0)" ::: "memory");
        } else {
            XB_SPIN(xb_ld(&bar[XB_XGEN(b.x)]) == gen, bar);
            __builtin_amdgcn_fence(__ATOMIC_ACQUIRE, "agent");
            asm volatile("s_waitcnt vmcnt(0)" ::: "memory");
        }
    }
    __syncthreads();
}


__device__ __forceinline__ void ln_load(const bf16_t* T, const bf16_t* XBo, const bf16_t* PARTp, float pscale, int row, int lane, float (&v)[32]) {
    if (row >= MP) {
#pragma unroll
        for (int j = 0; j < 4; ++j) { const int c = 512 * j + 8 * lane; const u32x4 xw = *(const u32x4*)(XBo + (size_t)row * DM + c); const bf16_t* pp = PARTp + (size_t)(row - MP) * DM + c;
            const u32x4 s0 = *(const u32x4*)pp, s1 = *(const u32x4*)(pp + (size_t)MS * DM), s2 = *(const u32x4*)(pp + (size_t)2 * MS * DM), s3 = *(const u32x4*)(pp + (size_t)3 * MS * DM);
            const unsigned xv[4] = {xw.x, xw.y, xw.z, xw.w}, a0[4] = {s0.x, s0.y, s0.z, s0.w}, a1[4] = {s1.x, s1.y, s1.z, s1.w}, a2[4] = {s2.x, s2.y, s2.z, s2.w}, a3[4] = {s3.x, s3.y, s3.z, s3.w};
#pragma unroll
            for (int e = 0; e < 4; ++e) { v[8 * j + 2 * e] = bflo(xv[e]) * ALPHA + ((bflo(a0[e]) + bflo(a1[e])) + (bflo(a2[e]) + bflo(a3[e]))) * pscale;
                v[8 * j + 2 * e + 1] = bfhi(xv[e]) * ALPHA + ((bfhi(a0[e]) + bfhi(a1[e])) + (bfhi(a2[e]) + bfhi(a3[e]))) * pscale; } }
    } else {
#pragma unroll
        for (int j = 0; j < 4; ++j) { const u32x4 tw = *(const u32x4*)(T + (size_t)row * DM + 512 * j + 8 * lane);
            v[8 * j + 0] = bflo(tw.x); v[8 * j + 1] = bfhi(tw.x); v[8 * j + 2] = bflo(tw.y); v[8 * j + 3] = bfhi(tw.y); v[8 * j + 4] = bflo(tw.z); v[8 * j + 5] = bfhi(tw.z); v[8 * j + 6] = bflo(tw.w); v[8 * j + 7] = bfhi(tw.w); }
    }
}
__device__ __forceinline__ void ln_store(bf16_t* XBo, float* Y, const float (&g)[32], const float (&bb)[32], int row, int lane, float (&v)[32], float mu, float r) {
#pragma unroll
    for (int j = 0; j < 4; ++j) { const int c = 512 * j + 8 * lane;
        const f32x4 o0 = ((f32x4){v[8 * j], v[8 * j + 1], v[8 * j + 2], v[8 * j + 3]} - mu) * r * (f32x4){g[8 * j], g[8 * j + 1], g[8 * j + 2], g[8 * j + 3]} + (f32x4){bb[8 * j], bb[8 * j + 1], bb[8 * j + 2], bb[8 * j + 3]};
        const f32x4 o1 = ((f32x4){v[8 * j + 4], v[8 * j + 5], v[8 * j + 6], v[8 * j + 7]} - mu) * r * (f32x4){g[8 * j + 4], g[8 * j + 5], g[8 * j + 6], g[8 * j + 7]} + (f32x4){bb[8 * j + 4], bb[8 * j + 5], bb[8 * j + 6], bb[8 * j + 7]};
        if (Y) { *(f32x4*)(Y + (size_t)row * DM + c) = o0; *(f32x4*)(Y + (size_t)row * DM + c + 4) = o1; }
        else *(u32x4*)(XBo + (size_t)row * DM + c) = pack8(o0, o1); }
}
__device__ __forceinline__ void ln_pass(const bf16_t* T, bf16_t* XBo, float* Y, const bf16_t* PARTp, float pscale, const float* lg, const float* lb, int gw, int NGW, int lane) {
    float g[32], bb[32];
#pragma unroll
    for (int j = 0; j < 4; ++j) { const int c = 512 * j + 8 * lane; const f32x4 g0 = *(const f32x4*)(lg + c), g1 = *(const f32x4*)(lg + c + 4), b0 = *(const f32x4*)(lb + c), b1 = *(const f32x4*)(lb + c + 4);
#pragma unroll
        for (int e = 0; e < 4; ++e) { g[8 * j + e] = g0[e]; g[8 * j + 4 + e] = g1[e]; bb[8 * j + e] = b0[e]; bb[8 * j + 4 + e] = b1[e]; } }
    const int nk = (MT - gw + NGW - 1) / NGW;
    for (int q = 0; q < nk; q += 2) {
        const int kA = q == 0 ? nk - 1 : q - 1, kB = q; const bool hasB = q + 1 < nk; const int row = gw + kA * NGW, rowB = gw + kB * NGW; const int rB = hasB ? rowB : row;
        float va[32], vb[32];
        ln_load(T, XBo, PARTp, pscale, row, lane, va); ln_load(T, XBo, PARTp, pscale, rB, lane, vb);
        float sa = 0.f, sb = 0.f;
#pragma unroll
        for (int e = 0; e < 32; ++e) { sa += va[e]; sb += vb[e]; }
        const float mua = wave_sum(sa) * (1.f / DM), mub = wave_sum(sb) * (1.f / DM); float qa = 0.f, qb = 0.f;
#pragma unroll
        for (int e = 0; e < 32; ++e) { const float da = va[e] - mua, db = vb[e] - mub; qa += da * da; qb += db * db; }
        const float ra = 1.f / sqrtf(wave_sum(qa) * (1.f / DM) + LN_EPS), rb_ = 1.f / sqrtf(wave_sum(qb) * (1.f / DM) + LN_EPS);
        ln_store(XBo, Y, g, bb, row, lane, va, mua, ra);
        if (hasB) ln_store(XBo, Y, g, bb, rowB, lane, vb, mub, rb_);
    }
}

__device__ __forceinline__ void transpose_item(const GAS float* W, int K, int N, GAS bf16_t* WT, int ldt, int coff, int map, int p0, int item, int lane) {
    const int nblk = (N + 63) >> 6, kc = item / nblk, nb = item - kc * nblk, n = nb * 64 + lane, k0 = kc * 256, k1 = (k0 + 256 < K) ? k0 + 256 : K;
    if (n < N) {
        int drow;
        if (map == 0) drow = n + p0;
        else if (map == 1) drow = (n >> 7) * 256 + (n & 127) + p0;
        else if (map == 2) drow = n < 768 ? n : (n < 800 ? 2816 + (n - 768) : n - 32);
        else { const int h = n / 96, e = n - h * 96; if (e < 64) drow = h * 64 + e; else { const int i2 = e - 64; drow = 1024 + h * 32 + 8 * ((i2 & 15) >> 2) + 4 * (i2 >> 4) + (i2 & 3); } }
        const GAS float* src = W + (size_t)k0 * N + n; GAS bf16_t* dst = WT + (size_t)drow * ldt + coff + k0;
#pragma unroll 4
        for (int k = k0; k < k1; k += 8) { float v[8];
#pragma unroll
            for (int j = 0; j < 8; ++j) v[j] = src[(size_t)j * N];
            u32x4 o; o.x = pk2(v[0], v[1]); o.y = pk2(v[2], v[3]); o.z = pk2(v[4], v[5]); o.w = pk2(v[6], v[7]);
            *(GAS u32x4*)dst = o; src += (size_t)8 * N; dst += 8; }
    }
}
struct Args { const float* in[40]; float* out; unsigned char* ws; };

struct SsmLam { double lr, li, dt; };
__device__ __forceinline__ SsmLam ssm_lam(const float* lam_re, const float* lam_im, const float* log_dt, int g, int p) { SsmLam s; s.lr = lam_re[g * 64 + p]; s.li = lam_im[g * 64 + p]; s.dt = dexp((double)log_dt[g]); return s; }
__device__ __forceinline__ void ssm_pow(const SsmLam& s, int k, double& wr, double& wi) { const double mag = dexp(s.lr * s.dt * k); double sn, cs; dsincos(s.li * s.dt * k, sn, cs); wr = mag * cs; wi = mag * sn; }
__device__ __forceinline__ void ssm_co(const SsmLam& s, double& cr, double& ci) { double ar, ai; ssm_pow(s, 1, ar, ai); const double den = s.lr * s.lr + s.li * s.li, nr = ar - 1.0; cr = (nr * s.lr + ai * s.li) / den; ci = (ai * s.lr - nr * s.li) / den; }

#define WUP ((bf16_t*)(ws + WS_WUP))
#define WDN ((bf16_t*)(ws + WS_WDN))
#define WINE ((bf16_t*)(ws + WS_WINE))
#define WOUTE ((bf16_t*)(ws + WS_WOUTE))
#define WINO ((bf16_t*)(ws + WS_WINO))
#define WOUTO ((bf16_t*)(ws + WS_WOUTO))
#define WMIXS ((bf16_t*)(ws + WS_WMIXS))
#define AEXPK ((bf16_t*)(ws + WS_AEXPK))
#define AEXPV ((bf16_t*)(ws + WS_AEXPV))
#define WQLAT ((bf16_t*)(ws + WS_WQLAT))
#define WPOOL ((bf16_t*)(ws + WS_WPOOL))
#define WUQ ((bf16_t*)(ws + WS_WUQ))
#define WKV ((bf16_t*)(ws + WS_WKV))
#define WUQN ((bf16_t*)(ws + WS_WUQN))
#define WGLU ((bf16_t*)(ws + WS_WGLU))
#define WSG ((bf16_t*)(ws + WS_WSG))
#define BT1 ((bf16_t*)(ws + WS_BT1))
#define BT2 ((bf16_t*)(ws + WS_BT2))
#define ROPE ((float*)(ws + WS_ROPE))
#define KTAB ((float*)(ws + WS_KTAB))
#define A64 ((float*)(ws + WS_A64))
#define XB ((bf16_t*)(ws + WS_XB))
#define HB ((bf16_t*)(ws + WS_H))
#define ZP ((bf16_t*)(ws + WS_ZP))
#define DP ((bf16_t*)(ws + WS_DP))
#define UP ((bf16_t*)(ws + WS_UP))
#define S1 ((float*)(ws + WS_S1))
#define GACT ((bf16_t*)(ws + WS_GACT))
#define ZQ ((bf16_t*)(ws + WS_ZQ))
#define ZC ((bf16_t*)(ws + WS_ZC))
#define ZK ((float*)(ws + WS_ZK))
#define UB ((bf16_t*)(ws + WS_UB))
#define VPRE ((bf16_t*)(ws + WS_VPRE))
#define VB ((bf16_t*)(ws + WS_VB))
#define CQN ((bf16_t*)(ws + WS_CQN))
#define CKVB ((bf16_t*)(ws + WS_CKVB))
#define KPEB ((bf16_t*)(ws + WS_KPEB))
#define AS ((bf16_t*)(ws + WS_AS))
#define PART ((bf16_t*)(ws + WS_PART))
#define KP ((bf16_t*)(ws + WS_KP))
#define QP ((bf16_t*)(ws + WS_QP))
#define QS ((bf16_t*)(ws + WS_QS))
#define VP ((bf16_t*)(ws + WS_VP))
#define KXS ((bf16_t*)(ws + WS_KXS))
#define TB ((bf16_t*)out)
#define MIX ((bf16_t*)((unsigned char*)out + 136 * MiB))
#define TFIN ((bf16_t*)(ws + 8 * MiB))
typedef const __attribute__((address_space(4))) Args* ArgsP;
#define PHASE_BEGIN() ArgsP ap = kap; asm volatile("" : "+s"(ap)); unsigned char* const ws = ap->ws; float* const out = ap->out; (void)ws; (void)out; \
    int tid = threadIdx.x; asm volatile("" : "+v"(tid)); int bx = blockIdx.x; asm volatile("" : "+s"(bx)); int G = gridDim.x; asm volatile("" : "+s"(G)); \
    const int lane = tid & 63, wave = __builtin_amdgcn_readfirstlane(tid >> 6), vcu = (G % 8 == 0) ? (bx % 8) * (G / 8) + bx / 8 : bx, gw = bx * NW + wave, NGW = G * NW; \
    const long gt = (long)bx * (NW * 64) + tid, NGT = (long)G * NW * 64; (void)lane; (void)wave; (void)vcu; (void)gw; (void)NGW; (void)gt; (void)NGT
__global__ void __launch_bounds__(NW * 64, 2) fwd_kernel(Args a_unused) {
    extern __shared__ __attribute__((aligned(16))) unsigned char lds_raw[];
    LAS unsigned char* lds = (LAS unsigned char*)lds_raw;
    volatile LAS unsigned* MISC = (volatile LAS unsigned*)(lds + LDSCTL_OFF);
    const ArgsP kap = (ArgsP)__builtin_amdgcn_kernarg_segment_ptr();
    unsigned* ctl = (unsigned*)(kap->ws + WS_CTL);
    if (threadIdx.x < 64) MISC[threadIdx.x] = 0u;
    __syncthreads();
    XcdBarrier bar = xcd_barrier_post(ctl + CW_BAR, MISC + 8);
#define GRID_BAR() do { XcdBarrier b_ = bar; asm volatile("" : "+s"(b_.bar), "+s"(b_.x)); xcd_barrier(b_); } while (0)

    { PHASE_BEGIN();
    {
        LAS unsigned long long* jsrc = (LAS unsigned long long*)(lds + 72 * 1024); LAS unsigned long long* jdst = jsrc + 32;
        LAS int* jK = (LAS int*)(jdst + 32); LAS int* jN = jK + 32; LAS int* jld = jN + 32; LAS int* jco = jld + 32; LAS int* jmap = jco + 32; LAS int* jp0 = jmap + 32; LAS int* jst = jp0 + 32;
        if (tid == 0) {
            int nj = 0, st = 0;
#define ADDJOB(src_, K_, N_, dst_, ld_, co_, map_, p0_) do { jsrc[nj] = (unsigned long long)(uintptr_t)(src_); jdst[nj] = (unsigned long long)(uintptr_t)(dst_); jK[nj] = (K_); jN[nj] = (N_); jld[nj] = (ld_); jco[nj] = (co_); \
                jmap[nj] = (map_); jp0[nj] = (p0_); jst[nj] = st; st += (((K_) + 255) / 256) * (((N_) + 63) / 64); ++nj; } while (0)
            for (int l = 0; l < 1; ++l) for (int f = 0; f < 1; ++f) { const int idx = l * 2 + f;
                ADDJOB(ap->in[9 + 3 * f] + (size_t)l * DM * FF, DM, FF, WUP + (size_t)idx * 11264 * DM, DM, 0, 1, 0);
                ADDJOB(ap->in[10 + 3 * f] + (size_t)l * DM * FF, DM, FF, WUP + (size_t)idx * 11264 * DM, DM, 0, 1, 128);
                ADDJOB(ap->in[11 + 3 * f] + (size_t)l * FF * DM, FF, DM, WDN + (size_t)idx * DM * FF, FF, 0, 0, 0); }
            ADDJOB(ap->in[15], DM, DM, WINE, DM, 0, 0, 0);
            for (int g = 0; g < 4; ++g) ADDJOB(ap->in[16] + (size_t)g * 384 * 384, 384, 384, WPOOL + (size_t)g * 512 * 384, 384, 0, 0, 0);
            ADDJOB(ap->in[26], 512, 512, WGLU, 512, 0, 0, 0);
            ADDJOB(ap->in[28], DM, DM, WOUTE, DM, 0, 0, 0);
            ADDJOB(ap->in[29], DM, 2848, WINO, DM, 0, 2, 0);
            ADDJOB(ap->in[32], 512, 1536, WUQ, 512, 0, 3, 0);
            ADDJOB(ap->in[33], 256, 1024, WKV, 256, 0, 0, 0);
            ADDJOB(ap->in[34], 256, 1024, WKV, 256, 0, 0, 1024);
            ADDJOB(ap->in[39], DM, DM, WOUTO, DM, 0, 0, 0);
            ADDJOB(ap->in[39] + (size_t)1024 * DM, 1024, DM, WMIXS, 5120, 4096, 0, 0);
            jst[nj] = st; jK[31] = nj;
#undef ADDJOB
        }
        __syncthreads();
        const int njobs = jK[31], total = jst[njobs];
        int jc = 0;
        for (int it = gw; it < total; it += NGW) {
            while (it >= jst[jc + 1]) ++jc;
            const GAS float* W = (const GAS float*)(uintptr_t)jsrc[jc]; GAS bf16_t* WT = (GAS bf16_t*)(uintptr_t)jdst[jc];
            const int K = jK[jc], N = jN[jc], ldt = jld[jc], coff = jco[jc], map = jmap[jc], p0 = jp0[jc], item = it - jst[jc];
            transpose_item(W, K, N, WT, ldt, coff, map, p0, item, lane);
        }
        for (long i = gt; i < (long)MT * DM / 8; i += NGT) { const long e = i * 8; const float* src = e < (long)MP * DM ? ap->in[0] + e : ap->in[1] + (e - (long)MP * DM);
            const f32x4 v0 = *(const f32x4*)src, v1 = *(const f32x4*)(src + 4); *(u32x4*)(XB + e) = pack8(v0, v1); }
        for (long i = gt; i < 512 * 1024 / 8; i += NGT) { const int s = (int)(i / 128), c = (int)(i % 128) * 8, h = c >> 6, d = c & 63; const float* src = ap->in[32] + (size_t)s * 1536 + h * 96 + d;
            *(u32x4*)(WUQN + (size_t)s * 1024 + c) = pack8(*(const f32x4*)src, *(const f32x4*)(src + 4)); }
        for (long i = gt; i < 2L * 4096 * 1024 / 8; i += NGT) { const int which = (int)(i / (4096 * 128)); const long r = i % (4096 * 128); const int mrow = (int)(r / 128), c = (int)(r % 128) * 8, h = mrow >> 8, rr = mrow & 255;
            u32x4 w = (u32x4){0u, 0u, 0u, 0u};
            if ((c >> 6) == h) { const float* src = ap->in[which ? 34 : 33] + (size_t)rr * 1024 + c; w = pack8(*(const f32x4*)src, *(const f32x4*)(src + 4)); }
            *(u32x4*)((which ? AEXPV : AEXPK) + (size_t)mrow * 1024 + c) = w; }
        for (long i = gt; i < 8 * 128 * 128; i += NGT) { const int s = (int)(i & 127), t = (int)((i >> 7) & 127); WSG[i] = (bf16_t)(s <= t ? f2bf(ap->in[37][i]) : 0u); }
        for (long i = gt; i < 16384 * 16; i += NGT) { const int pos = (int)(i >> 4), f = (int)(i & 15); const float inv = (float)dexp(-(double)f * (9.210340371976184 / 16.0)); const float ang = (float)pos * inv;
            double sn, cs; dsincos((double)ang, sn, cs); ROPE[(size_t)pos * 32 + f] = (float)cs; ROPE[(size_t)pos * 32 + 16 + f] = (float)sn; }
        for (long i = gt; i < 32 * 64 * 64; i += NGT) { const int ii = (int)(i & 63), p = (int)((i >> 6) & 63), g = (int)(i >> 12);
            const SsmLam L = ssm_lam(ap->in[18], ap->in[19], ap->in[20], g, p); double cr, ci, wr_, wi_; ssm_co(L, cr, ci); ssm_pow(L, 63 - ii, wr_, wi_);
            const double fr_ = wr_ * cr - wi_ * ci, fi_ = wr_ * ci + wi_ * cr;
            float re[16], im[16];
#pragma unroll
            for (int c = 0; c < 16; ++c) { const double br = ap->in[21][(size_t)(g * 64 + p) * 16 + c], bi = ap->in[22][(size_t)(g * 64 + p) * 16 + c]; re[c] = (float)(fr_ * br - fi_ * bi); im[c] = (float)(fr_ * bi + fi_ * br); }
            bf16_t* d0 = BT1 + ((size_t)g * 256 + p) * 1024 + (63 - ii) * 16; bf16_t* d1 = BT1 + ((size_t)g * 256 + 64 + p) * 1024 + (63 - ii) * 16;
            *(u32x4*)d0 = pack8((f32x4){re[0], re[1], re[2], re[3]}, (f32x4){re[4], re[5], re[6], re[7]}); *(u32x4*)(d0 + 8) = pack8((f32x4){re[8], re[9], re[10], re[11]}, (f32x4){re[12], re[13], re[14], re[15]});
            *(u32x4*)d1 = pack8((f32x4){im[0], im[1], im[2], im[3]}, (f32x4){im[4], im[5], im[6], im[7]}); *(u32x4*)(d1 + 8) = pack8((f32x4){im[8], im[9], im[10], im[11]}, (f32x4){im[12], im[13], im[14], im[15]}); }
        for (long i = gt; i < 32 * 64 * 64; i += NGT) { const int p = (int)(i & 63), j = (int)((i >> 6) & 63), g = (int)(i >> 12);
            const SsmLam L = ssm_lam(ap->in[18], ap->in[19], ap->in[20], g, p); double wr_, wi_; ssm_pow(L, j + 1, wr_, wi_);
#pragma unroll
            for (int c = 0; c < 16; ++c) { const double cr = ap->in[23][(size_t)(g * 16 + c) * 64 + p], ci = ap->in[24][(size_t)(g * 16 + c) * 64 + p];
                bf16_t* d = BT2 + ((size_t)g * 1024 + j * 16 + c) * 1152 + 1024 + p; d[0] = (bf16_t)f2bf((float)(cr * wr_ - ci * wi_)); d[64] = (bf16_t)f2bf((float)(-(cr * wi_ + ci * wr_))); } }
        for (long i = gt; i < 32 * 64; i += NGT) { const SsmLam L = ssm_lam(ap->in[18], ap->in[19], ap->in[20], (int)(i >> 6), (int)(i & 63)); double wr_, wi_; ssm_pow(L, 64, wr_, wi_); A64[i * 2] = (float)wr_; A64[i * 2 + 1] = (float)wi_; }
        for (int item = bx; item < 256; item += G) {
            const int g = item >> 3, kq = item & 7;
            LAS float* sB = (LAS float*)(lds + 80 * 1024);
            LAS float* sC = sB + 2048;
            LAS float* sW = sC + 2048;
            for (int e = tid; e < 1024; e += NW * 64) { const int p = e >> 4, c = e & 15; const SsmLam L = ssm_lam(ap->in[18], ap->in[19], ap->in[20], g, p); double cr, ci; ssm_co(L, cr, ci);
                const double br = ap->in[21][(size_t)(g * 64 + p) * 16 + c], bi = ap->in[22][(size_t)(g * 64 + p) * 16 + c]; sB[e * 2] = (float)(cr * br - ci * bi); sB[e * 2 + 1] = (float)(cr * bi + ci * br);
                const int c2 = e >> 6, p2 = e & 63; sC[e * 2] = ap->in[23][(size_t)(g * 16 + c2) * 64 + p2]; sC[e * 2 + 1] = ap->in[24][(size_t)(g * 16 + c2) * 64 + p2]; }
            for (int kk = 0; kk < 8; ++kk) { const int k = kq * 8 + kk;
                __syncthreads();
                if (tid < 64) { const SsmLam L = ssm_lam(ap->in[18], ap->in[19], ap->in[20], g, tid); double wr_, wi_; ssm_pow(L, k, wr_, wi_); sW[tid * 2] = (float)wr_; sW[tid * 2 + 1] = (float)wi_; }
                __syncthreads();
                if (tid < 256) { const int c = tid >> 4, cp = tid & 15; float acc = 0.f;
                    for (int p = 0; p < 64; ++p) { const float cr = sC[(c * 64 + p) * 2], ci = sC[(c * 64 + p) * 2 + 1], wr_ = sW[p * 2], wi_ = sW[p * 2 + 1], br = sB[(p * 16 + cp) * 2], bi = sB[(p * 16 + cp) * 2 + 1];
                        const float tr = cr * wr_ - ci * wi_, ti = cr * wi_ + ci * wr_; acc += tr * br - ti * bi; }
                    if (k == 0 && c == cp) acc += ap->in[25][g * 16 + c];
                    KTAB[((size_t)g * 64 + k) * 256 + tid] = acc; } }
            __syncthreads();
        }
    }
    } GRID_BAR();

#pragma clang loop unroll(disable)
    for (int sl = 0; sl < 4; ++sl) {
        const int layer = sl >> 1, f = sl & 1;
        if (sl == 1) {
            { PHASE_BEGIN();
            { pg8::Gemm g{XB, WINE, DM, DM, DM}; pg8::TileOrder S; S.init(MT / 256, 8, G, bx); pg8::EpiZe E{ZP, UP, out}; pg8::gemm_phase(lds, g, S, E); }
            if (bx >= 64 && bx < 96) { pg8::Gemm g{AEXPK, WUQN, 1024, 1024, 1024}; pg8::TileOrder S; S.init(16, 2, 32, bx - 64); pg8::EpiPlain E{WQLAT, 512}; pg8::gemm_phase(lds, g, S, E); }
            if (bx >= 96) { pg8::Gemm g{WOUTO, AEXPV, 1024, DM, 1024}; pg8::TileOrder S; S.init(8, 16, 160, bx - 96); pg8::EpiPlain E{WMIXS, 5120}; pg8::gemm_phase(lds, g, S, E); }
            } GRID_BAR(); { PHASE_BEGIN();
            { pg8::Gemm g{UP, BT1, 1024, 1152, 1024}; pg8::GroupOrder S; S.init(32, 3, 1, 3, 1, G, bx); pg8::EpiS1 E{S1}; pg8::gemm_phase(lds, g, S, E); }
            for (int it = NGW - 1 - gw; it < 2176 * 3; it += NGW) {
                const int rb = it / 3, cg = it % 3, col = cg * 512 + lane * 8, pg = col / 384, w = 2 << pg, wmax = 4 << cg;
                const int row0 = rb * 16; const bool smp = row0 >= MP; const int t0 = smp ? ((row0 - MP) & 63) : (row0 & (SEQ - 1)); const int rowb = row0 - t0;
                const bf16_t* zb = ZP + (size_t)rowb * 1536 + col; bf16_t* dp = DP + ((size_t)pg * MT + row0) * 384 + (col - pg * 384);
                const float icw = 1.f / (float)w;
                float sm[8];
#pragma unroll
                for (int e = 0; e < 8; ++e) sm[e] = 0.f;
#define UNPK(W_, F_) do { F_[0] = bflo(W_.x); F_[1] = bfhi(W_.x); F_[2] = bflo(W_.y); F_[3] = bfhi(W_.y); F_[4] = bflo(W_.z); F_[5] = bfhi(W_.z); F_[6] = bflo(W_.w); F_[7] = bfhi(W_.w); } while (0)
                if (t0 >= 15) {
                    u32x4 pz[15];
#pragma unroll
                    for (int k = 1; k < 16; ++k) pz[k - 1] = *(const u32x4*)(zb + (size_t)(t0 - (k < wmax ? k : 1)) * 1536);
#pragma unroll
                    for (int k = 1; k < 16; ++k) { float f[8]; UNPK(pz[k - 1], f); const float mk = k < w ? 1.f : 0.f;
#pragma unroll
                        for (int e = 0; e < 8; ++e) sm[e] += mk * f[e]; }
#pragma unroll
                    for (int r8 = 0; r8 < 16; r8 += 8) { u32x4 za[8], ya[8];
#pragma unroll
                        for (int i = 0; i < 8; ++i) { za[i] = *(const u32x4*)(zb + (size_t)(t0 + r8 + i) * 1536); ya[i] = *(const u32x4*)(zb + (size_t)(t0 + r8 + i - w + 1) * 1536); }
#pragma unroll
                        for (int i = 0; i < 8; ++i) { float f[8], y[8]; UNPK(za[i], f); UNPK(ya[i], y);
#pragma unroll
                            for (int e = 0; e < 8; ++e) sm[e] += f[e];
                            *(u32x4*)(dp + (size_t)(r8 + i) * 384) = pack8((f32x4){sm[0] * icw - f[0], sm[1] * icw - f[1], sm[2] * icw - f[2], sm[3] * icw - f[3]}, (f32x4){sm[4] * icw - f[4], sm[5] * icw - f[5], sm[6] * icw - f[6], sm[7] * icw - f[7]});
#pragma unroll
                            for (int e = 0; e < 8; ++e) sm[e] -= y[e]; } }
                } else {
                    const float* hist = ap->in[2] + (size_t)(smp ? ((row0 - MP) >> 6) : 0) * 15 * 1536 + col;
#define ZF8(tt, F_) do { const int tt_ = (tt); if (tt_ >= 0) { const u32x4 z_ = *(const u32x4*)(zb + (size_t)tt_ * 1536); UNPK(z_, F_); } \
                        else if (smp) { const f32x4 h0_ = *(const f32x4*)(hist + (size_t)(15 + tt_) * 1536), h1_ = *(const f32x4*)(hist + (size_t)(15 + tt_) * 1536 + 4); \
                            F_[0] = h0_[0]; F_[1] = h0_[1]; F_[2] = h0_[2]; F_[3] = h0_[3]; F_[4] = h1_[0]; F_[5] = h1_[1]; F_[6] = h1_[2]; F_[7] = h1_[3]; } \
                        else { _Pragma("unroll") for (int e_ = 0; e_ < 8; ++e_) F_[e_] = 0.f; } } while (0)
                    for (int k = 1; k < w; ++k) { float f[8]; ZF8(t0 - k, f);
#pragma unroll
                        for (int e = 0; e < 8; ++e) sm[e] += f[e]; }
                    for (int i = 0; i < 16; ++i) { const int t = t0 + i; float f[8], y[8]; ZF8(t, f); ZF8(t - w + 1, y);
                        const float ic = (smp || t + 1 >= w) ? icw : 1.f / (float)(t + 1);
#pragma unroll
                        for (int e = 0; e < 8; ++e) sm[e] += f[e];
                        *(u32x4*)(dp + (size_t)i * 384) = pack8((f32x4){sm[0] * ic - f[0], sm[1] * ic - f[1], sm[2] * ic - f[2], sm[3] * ic - f[3]}, (f32x4){sm[4] * ic - f[4], sm[5] * ic - f[5], sm[6] * ic - f[6], sm[7] * ic - f[7]});
#pragma unroll
                        for (int e = 0; e < 8; ++e) sm[e] -= y[e]; }
#undef ZF8
                }
#undef UNPK
            }
            } GRID_BAR(); { PHASE_BEGIN();
            if (wave == 0 && bx >= G - 64) {
                const int cb_ = bx - (G - 64), b = cb_ >> 5, g = cb_ & 31, p = lane; const float ar = A64[(g * 64 + p) * 2], ai = A64[(g * 64 + p) * 2 + 1];
                float hr = 0.f, hi_ = 0.f;
                for (int kb = 0; kb < 256; kb += 16) { float sr[16], si[16];
#pragma unroll
                    for (int j = 0; j < 16; ++j) { const size_t row = (size_t)g * 768 + b * 256 + kb + j; sr[j] = S1[row * 128 + p]; si[j] = S1[row * 128 + 64 + p]; }
#pragma unroll
                    for (int j = 0; j < 16; ++j) { const size_t row = (size_t)g * 768 + b * 256 + kb + j;
                        UP[row * 1152 + 1024 + p] = (bf16_t)f2bf(hr); UP[row * 1152 + 1088 + p] = (bf16_t)f2bf(hi_);
                        const float nr = ar * hr - ai * hi_ + sr[j], ni = ar * hi_ + ai * hr + si[j]; hr = nr; hi_ = ni; } }
                out[O_SREP + (size_t)(b * 32 + g) * 64 + p] = hr; out[O_SIMP + (size_t)(b * 32 + g) * 64 + p] = hi_;
            } else if (bx >= 64 && bx < G - 64) {
                const int it = (bx - 64) * NW + wave;
                if (it < 1024) { const int b = it >> 5, g = it & 31, p = lane; const float ar = A64[(g * 64 + p) * 2], ai = A64[(g * 64 + p) * 2 + 1];
                    const float hr = ap->in[3][(size_t)(b * 32 + g) * 64 + p], hi_ = ap->in[4][(size_t)(b * 32 + g) * 64 + p]; const size_t row = (size_t)g * 768 + 512 + b;
                    UP[row * 1152 + 1024 + p] = (bf16_t)f2bf(hr); UP[row * 1152 + 1088 + p] = (bf16_t)f2bf(hi_);
                    const float sr = S1[row * 128 + p], si = S1[row * 128 + 64 + p];
                    out[O_SRES + (size_t)(b * 32 + g) * 64 + p] = ar * hr - ai * hi_ + sr; out[O_SIMS + (size_t)(b * 32 + g) * 64 + p] = ar * hi_ + ai * hr + si; }
            }
            { pg8::Gemm g{DP, WPOOL, 384, 384, 384}; pg8::GroupOrder S;
              if (G != 256) S.init(4, MT / 256, 2, MT / 256, 2, G, bx);
              else if (bx < 192) { S.init(4, MT / 256, 2, MT / 256, 2, 192, bx); S.total = 960; }
              else S.init(4, MT / 256, 2, MT / 256, 2, 64, 960 + bx - 192);
              pg8::EpiPool E{MIX, ap->in[17]}; pg8::gemm_phase(lds, g, S, E); }
            } GRID_BAR(); { PHASE_BEGIN();
            { pg8::Gemm g{UP, BT2, 1152, 1152, 1152}; pg8::EpiS2 E{GACT};
              if (G == 256) { pg8::S5Order S; S.init(bx); pg8::gemm_phase(lds, g, S, E); }
              else { pg8::GroupOrder S; S.init(32, 3, 4, 3, 4, G, bx); pg8::gemm_phase(lds, g, S, E); } }
            } GRID_BAR(); { PHASE_BEGIN();
            { pg8::Gemm g{GACT, WGLU, 512, 512, 512}; pg8::TileOrder S; S.init(MT / 256, 2, G, bx); pg8::EpiGlu E{GACT, ap->in[27], MIX}; pg8::gemm_phase(lds, g, S, E); }
            } GRID_BAR(); { PHASE_BEGIN();
            { pg8::Gemm g{MIX, WOUTE, DM, DM, DM}; pg8::SplitOrder S; S.init(MP / 256, MS / 256, 8, MP / 256, DM / 256, G, bx); pg8::EpiResid E{XB, TB, 1.f, 0, PART}; pg8::gemm_phase(lds, g, S, E); }
            } GRID_BAR();
        }
        if (sl == 3) {
            { PHASE_BEGIN();
            { pg8::Gemm g{XB, WINO, DM, DM, DM}; pg8::TileOrder S; S.init(MT / 256, 12, G, bx); pg8::EpiZo E{ZQ, ZC, ZK, UB, VPRE}; pg8::gemm_phase(lds, g, S, E); }
            } GRID_BAR(); { PHASE_BEGIN();
            for (long i0 = gt; i0 < 32L * 4096 * 36; i0 += 4 * NGT) {
                f32x4 ca[4], cb[4];
#pragma unroll
                for (int k = 0; k < 4; ++k) { const long i = i0 + k * NGT; if (i < 32L * 4096 * 36) { const int ch = (int)(i % 36); const long rowc = i / 36;
                    const float* src = ch < 32 ? ap->in[5] + (size_t)rowc * 256 + ch * 8 : ap->in[6] + (size_t)rowc * 32 + (ch - 32) * 8; ca[k] = *(const f32x4*)src; cb[k] = *(const f32x4*)(src + 4); } else { ca[k] = f32x4{}; cb[k] = f32x4{}; } }
#pragma unroll
                for (int k = 0; k < 4; ++k) { const long i = i0 + k * NGT; if (i < 32L * 4096 * 36) { const int ch = (int)(i % 36); const long rowc = i / 36; const int b = (int)(rowc >> 12), t = (int)(rowc & 4095);
                    *(u32x4*)(KXS + ((size_t)b * 4160 + t) * 288 + ch * 8) = pack8(ca[k], cb[k]); } }
            }
            const f32x4 gq0 = *(const f32x4*)(ap->in[30] + 4 * lane), gq1 = *(const f32x4*)(ap->in[30] + 256 + 4 * lane), gkv = *(const f32x4*)(ap->in[31] + 4 * lane);
            f32x4 gv[4], bv[4];
#pragma unroll
            for (int hf = 0; hf < 2; ++hf) { const int c0 = hf * 512 + 8 * lane; gv[2 * hf] = *(const f32x4*)(ap->in[35] + c0); gv[2 * hf + 1] = *(const f32x4*)(ap->in[35] + c0 + 4); bv[2 * hf] = *(const f32x4*)(ap->in[36] + c0); bv[2 * hf + 1] = *(const f32x4*)(ap->in[36] + c0 + 4); }
            for (int row = gw; row < MT; row += NGW) {
                const bool smp = row >= MP; const int rs = row - MP, sb = rs >> 6, st = rs & 63; const int pos = smp ? 4096 + st : (row & (SEQ - 1));
                bf16_t* kx = KXS + ((size_t)sb * 4160 + 4096 + st) * 288;
                const bf16_t* zq = ZQ + (size_t)row * 512; const u32x2 q0w = *(const u32x2*)(zq + 4 * lane), q1w = *(const u32x2*)(zq + 256 + 4 * lane), cvw = *(const u32x2*)(ZC + (size_t)row * 256 + 4 * lane);
                const f32x4 q0 = {bflo(q0w.x), bfhi(q0w.x), bflo(q0w.y), bfhi(q0w.y)}, q1 = {bflo(q1w.x), bfhi(q1w.x), bflo(q1w.y), bfhi(q1w.y)}, cv = {bflo(cvw.x), bfhi(cvw.x), bflo(cvw.y), bfhi(cvw.y)};
                const bf16_t* zv = VPRE + (size_t)row * 1024; const u32x4 wa = *(const u32x4*)(zv + 8 * lane), wb = *(const u32x4*)(zv + 512 + 8 * lane);
                float x1 = 0.f, x2 = 0.f, cs = 0.f, sn = 0.f;
                if (lane < 16) { x1 = ZK[(size_t)row * 32 + lane]; x2 = ZK[(size_t)row * 32 + 16 + lane]; cs = ROPE[(size_t)pos * 32 + lane]; sn = ROPE[(size_t)pos * 32 + 16 + lane]; }
                float v[16] = {bflo(wa.x), bfhi(wa.x), bflo(wa.y), bfhi(wa.y), bflo(wa.z), bfhi(wa.z), bflo(wa.w), bfhi(wa.w), bflo(wb.x), bfhi(wb.x), bflo(wb.y), bfhi(wb.y), bflo(wb.z), bfhi(wb.z), bflo(wb.w), bfhi(wb.w)};
                float ssq = (q0[0] * q0[0] + q0[1] * q0[1]) + (q0[2] * q0[2] + q0[3] * q0[3]) + (q1[0] * q1[0] + q1[1] * q1[1]) + (q1[2] * q1[2] + q1[3] * q1[3]);
                float ssc = (cv[0] * cv[0] + cv[1] * cv[1]) + (cv[2] * cv[2] + cv[3] * cv[3]);
                float sv = 0.f;
#pragma unroll
                for (int e = 0; e < 16; ++e) sv += v[e];
                ssq = wave_sum(ssq); ssc = wave_sum(ssc); sv = wave_sum(sv);
                const float mu = sv * (1.f / 1024); float s2 = 0.f;
#pragma unroll
                for (int e = 0; e < 16; ++e) { v[e] -= mu; s2 += v[e] * v[e]; }
                { const float r = 1.f / sqrtf(ssq * (1.f / 512) + RMS_EPS);
                  const f32x4 o0 = q0 * r * gq0, o1 = q1 * r * gq1; u32x2 w0, w1; w0.x = pk2(o0[0], o0[1]); w0.y = pk2(o0[2], o0[3]); w1.x = pk2(o1[0], o1[1]); w1.y = pk2(o1[2], o1[3]);
                  *(u32x2*)(CQN + (size_t)row * 512 + 4 * lane) = w0; *(u32x2*)(CQN + (size_t)row * 512 + 256 + 4 * lane) = w1; }
                { const float r = 1.f / sqrtf(ssc * (1.f / 256) + RMS_EPS); const f32x4 o = cv * r * gkv;
                  *(f32x4*)(out + (smp ? O_CKVS + (size_t)rs * 256 : O_CKVP + (size_t)row * 256) + 4 * lane) = o;
                  u32x2 w; w.x = pk2(o[0], o[1]); w.y = pk2(o[2], o[3]); *(u32x2*)((smp ? kx : CKVB + (size_t)row * 256) + 4 * lane) = w; }
                if (lane < 16) {
                  const float o1 = x1 * cs - x2 * sn, o2 = x2 * cs + x1 * sn; float* op = out + (smp ? O_KPES + (size_t)rs * 32 : O_KPEP + (size_t)row * 32); op[lane] = o1; op[16 + lane] = o2;
                  bf16_t* kb = smp ? kx + 256 : KPEB + (size_t)row * 32; kb[lane] = (bf16_t)f2bf(o1); kb[16 + lane] = (bf16_t)f2bf(o2); }
                { const float r = 1.f / sqrtf(wave_sum(s2) * (1.f / 1024) + LN_EPS);
#pragma unroll
                  for (int hf = 0; hf < 2; ++hf) { const int c0 = hf * 512 + 8 * lane; const f32x4 g0 = gv[2 * hf], g1 = gv[2 * hf + 1], b0 = bv[2 * hf], b1 = bv[2 * hf + 1];
                      const f32x4 o0 = (f32x4){v[hf * 8 + 0], v[hf * 8 + 1], v[hf * 8 + 2], v[hf * 8 + 3]} * r * g0 + b0, o1 = (f32x4){v[hf * 8 + 4], v[hf * 8 + 5], v[hf * 8 + 6], v[hf * 8 + 7]} * r * g1 + b1;
                      *(u32x4*)(VB + (size_t)row * 1024 + c0) = pack8(o0, o1);
                      if (smp) { float* op = out + O_SGVS + (size_t)rs * 1024 + c0; *(f32x4*)op = o0; *(f32x4*)(op + 4) = o1; } } }
            }
            } GRID_BAR(); { PHASE_BEGIN();
            { pg8::Gemm g{CQN, WUQ, 512, 512, 512}; pg8::TileOrder S; S.init(MP / 256, 6, G, bx); pg8::EpiQ E{QP, QS, ROPE}; pg8::gemm_phase(lds, g, S, E); }
            { pg8::Gemm g{CQN, WUQ, 512, 512, 512}; pg8::TileOrder S; S.init(MS / 256, 2, G, bx, MP / 256, 4); pg8::EpiQ E{QP, QS, ROPE}; pg8::gemm_phase(lds, g, S, E); }
            { pg8::Gemm g{CQN + (size_t)MP * 512, WQLAT, 512, 512, 512}; pg8::TileOrder S; S.init(MS / 256, 16, G, bx >= G / 2 ? bx - G / 2 : bx + G / 2); pg8::EpiQlat E{QS}; pg8::gemm_phase(lds, g, S, E); }
            { pg8::Gemm g{CKVB, WKV, 256, 256, 256}; pg8::TileOrder S; S.init(MP / 256, 8, G, bx); pg8::EpiKV E{KP, VP}; pg8::gemm_phase(lds, g, S, E); }
            {
                constexpr int RS = 320, IMG = 128 * RS;
                char* sl = (char*)lds_raw;
                const int tb = wave >> 1, cbp = wave & 1, r32 = lane & 31, hi = lane >> 5;
                const int vrd = (int)(unsigned)(uintptr_t)sl + (8 * hi + ((lane >> 2) & 3)) * RS + (64 * cbp + 16 * ((lane >> 4) & 1) + 4 * (lane & 3)) * 2;
                u32x4 sv[4];
#define SG_LOAD(un_) do { const bool smp_ = (un_) >= 2048; const int ch_ = smp_ ? ((un_) - 2048) >> 3 : (un_) >> 3, g_ = (un_) & 7, rb_ = smp_ ? MP + ch_ * 64 : ch_ * 128, nr_ = smp_ ? 64 : 128; \
                    _Pragma("unroll") for (int k = 0; k < 4; ++k) { const int idx = tid + 512 * k, row = (idx >> 4) & (nr_ - 1); sv[k] = *(const u32x4*)(VB + (size_t)(rb_ + row) * 1024 + g_ * 128 + (idx & 15) * 8); } } while (0)
#define SG_WRITE(bf_) do { _Pragma("unroll") for (int k = 0; k < 4; ++k) { const int idx = tid + 512 * k, row = idx >> 4; *(u32x4*)(sl + (bf_) * IMG + row * RS + (idx & 15) * 16) = sv[k]; } } while (0)
                __syncthreads();
                int un = vcu, bf = 0;
                SG_LOAD(un); SG_WRITE(0);
                __syncthreads();
                for (; un < 2048 + 256; un += G, bf ^= 1) {
                    const int unn = un + G; const bool more = unn < 2048 + 256;
                    { const int unl = more ? unn : un; SG_LOAD(unl); }
                    const bool smp = un >= 2048; const int ch = smp ? (un - 2048) >> 3 : un >> 3, g = un & 7; const int rowbase = smp ? MP + ch * 64 : ch * 128;
                    if (!(smp && tb >= 2)) {
                        f32x16 c0 = f32x16{}, c1 = f32x16{};
                        const int nks = 2 * (tb + 1); const int vb = vrd + bf * IMG;
                        const bf16_t* wp = WSG + ((size_t)g * 128 + 32 * tb + r32) * 128 + 8 * hi;
                        for (int ks = 0; ks < nks; ++ks) {
                            const bf16x8 wf = *(const bf16x8*)(wp + 16 * ks);
                            const int va = vb + ks * 16 * RS;
                            const s16x4 l0 = att::tr_read<0>(va), h0 = att::tr_read<4 * RS>(va), l1 = att::tr_read<64>(va), h1 = att::tr_read<4 * RS + 64>(va);
                            asm volatile("s_waitcnt lgkmcnt(0)" ::: "memory"); __builtin_amdgcn_sched_barrier(0);
#define PK(L, H) (bf16x8){L[0], L[1], L[2], L[3], H[0], H[1], H[2], H[3]}
                            c0 = __builtin_amdgcn_mfma_f32_32x32x16_bf16(PK(l0, h0), wf, c0, 0, 0, 0); c1 = __builtin_amdgcn_mfma_f32_32x32x16_bf16(PK(l1, h1), wf, c1, 0, 0, 0);
#undef PK
                        }
                        const int t = 32 * tb + r32; const float bs = ap->in[38][g * 128 + t]; const size_t row = (size_t)(rowbase + t);
                        const bf16_t* up = UB + row * 1024 + g * 128 + 64 * cbp + 4 * hi;
                        bf16_t* op = (smp ? AS + (size_t)(row - MP) * 5120 + 4096 : MIX + row * DM + 1024) + g * 128 + 64 * cbp + 4 * hi;
#pragma unroll
                        for (int i = 0; i < 4; ++i) {
                            const u32x2 ua = *(const u32x2*)(up + 8 * i), ub = *(const u32x2*)(up + 32 + 8 * i); u32x2 oa, ob;
                            oa.x = pk2((c0[4 * i + 0] + bs) * bflo(ua.x), (c0[4 * i + 1] + bs) * bfhi(ua.x)); oa.y = pk2((c0[4 * i + 2] + bs) * bflo(ua.y), (c0[4 * i + 3] + bs) * bfhi(ua.y));
                            ob.x = pk2((c1[4 * i + 0] + bs) * bflo(ub.x), (c1[4 * i + 1] + bs) * bfhi(ub.x)); ob.y = pk2((c1[4 * i + 2] + bs) * bflo(ub.y), (c1[4 * i + 3] + bs) * bfhi(ub.y));
                            *(u32x2*)(op + 8 * i) = oa; *(u32x2*)(op + 32 + 8 * i) = ob; }
                    }
                    SG_WRITE(bf ^ 1);
                    __syncthreads();
                }
#undef SG_LOAD
#undef SG_WRITE
            }
            } GRID_BAR(); { PHASE_BEGIN();
            {
                char* ldsg = (char*)lds_raw;
                const int r32 = lane & 31, hi = lane >> 5;
                { const int bh = vcu >> 3, s = vcu & 7, b = bh >> 4, h = bh & 15;
                  for (int i = 0; i < 8; ++i) { const int x = s + 8 * (i >> 1), qb = (i & 1) ? 63 - x : x; const size_t rb = (size_t)b * SEQ;
                      const size_t qrow = rb + (size_t)qb * 256 + wave * 32;
                      att::attn_unit_p2(ldsg, QP + (qrow + r32) * 1536 + h * 96 + hi * 8, KP + rb * 1024 + h * 64, KPEB + rb * 32, VP + rb * 1024 + h * 64, 4 * (qb + 1), 4 * qb + (wave >> 1), MIX + qrow * DM + h * 64, DM); } }
                { const int b = vcu >> 3, hp = vcu & 7, wq = wave & 3, wd = wave >> 2, head = 2 * hp + (wq >> 1); const size_t srow0 = (size_t)b * 64 + 32 * (wq & 1);
                  att::attn_unit<true>(ldsg, QS + (srow0 + r32) * 4608 + head * 288 + hi * 8, KXS + (size_t)b * 4160 * 288, nullptr, 65, 1 << 30,
                                       AS + srow0 * 5120 + head * 256 + 128 * wd, 5120, 4 * wd); }
            }
            } GRID_BAR(); { PHASE_BEGIN();
            { pg8::Gemm g{MIX, WOUTO, DM, DM, DM}; pg8::TileOrder S; S.init(MP / 256, 8, G, bx); pg8::EpiResid E{XB, TB, 1.f, 0, PART}; pg8::gemm_phase(lds, g, S, E); }
            { pg8::Gemm g{AS, WMIXS, 5120, 5120, 5120}; pg8::SplitOrder S; S.init(0, MS / 256, 8, 0, 5120 / 256, G, bx); pg8::EpiResid E{XB, TB, 1.f, MP, PART}; pg8::gemm_phase(lds, g, S, E); }
            } GRID_BAR();
        }
        if (sl == 1 || sl == 3) {
            { PHASE_BEGIN();
            ln_pass(TB, XB, nullptr, PART, 1.f, ap->in[7] + (size_t)(layer * 3 + 1) * DM, ap->in[8] + (size_t)(layer * 3 + 1) * DM, gw, NGW, lane);
            } GRID_BAR();
        }
        { PHASE_BEGIN();
        { pg8::Gemm g{XB, WUP + (size_t)sl * 11264 * DM, DM, DM, DM}; pg8::TileOrder S; S.init(MT / 256, 44, G, bx); pg8::EpiSwiglu E{HB}; pg8::gemm_phase(lds, g, S, E); }
        if (sl < 3 && bx >= 96) {
            const int idx = sl + 1, l2 = idx >> 1, f2 = idx & 1, lw = (bx - 96) * NW + wave, nlw = (G - 96) * NW;
            const GAS float* w1 = (const GAS float*)(ap->in[9 + 3 * f2] + (size_t)l2 * DM * FF); const GAS float* w3 = (const GAS float*)(ap->in[10 + 3 * f2] + (size_t)l2 * DM * FF); const GAS float* w2 = (const GAS float*)(ap->in[11 + 3 * f2] + (size_t)l2 * FF * DM);
            GAS bf16_t* du = (GAS bf16_t*)(WUP + (size_t)idx * 11264 * DM); GAS bf16_t* dd = (GAS bf16_t*)(WDN + (size_t)idx * DM * FF);
            for (int it = lw; it < 3 * 704; it += nlw) {
                if (it < 704) transpose_item(w1, DM, FF, du, DM, 0, 1, 0, it, lane);
                else if (it < 1408) transpose_item(w3, DM, FF, du, DM, 0, 1, 128, it - 704, lane);
                else transpose_item(w2, FF, DM, dd, FF, 0, 0, 0, it - 1408, lane); }
        }
        } GRID_BAR(); { PHASE_BEGIN();
        { pg8::Gemm g{HB, WDN + (size_t)sl * DM * FF, FF, FF, FF}; pg8::SplitOrder S; S.init(MP / 256, MS / 256, 8, MP / 256, FF / 256, G, bx);
          pg8::EpiResid E{XB, sl == 3 ? TFIN : TB, 0.5f, 0, PART}; pg8::gemm_phase(lds, g, S, E); }
        } GRID_BAR(); { PHASE_BEGIN();
            ln_pass(sl == 3 ? TFIN : TB, XB, sl == 3 ? out : nullptr, PART, 0.5f, ap->in[7] + (size_t)(layer * 3 + 2 * f) * DM, ap->in[8] + (size_t)(layer * 3 + 2 * f) * DM, gw, NGW, lane);
            if (sl == 0) {
                for (long i = gt; i < 32L * 1024 * 128; i += NGT) { const int kc = (int)(i & 127), n = (int)((i >> 7) & 1023), g = (int)(i >> 17); const int j = n >> 4, c = n & 15, ii = 63 - (kc >> 1), cp = (kc & 1) * 8;
                    u32x4 w = (u32x4){0u, 0u, 0u, 0u};
                    if (ii <= j) { const float* kt = KTAB + ((size_t)g * 64 + (j - ii)) * 256 + c * 16 + cp; w = pack8(*(const f32x4*)kt, *(const f32x4*)(kt + 4)); }
                    *(u32x4*)(BT2 + ((size_t)g * 1024 + n) * 1152 + kc * 8) = w; }
            }
        } GRID_BAR();
    }
}

extern "C" void kernel_launch(void* const* d_in, const int* in_sizes, int n_in, void* d_out, int out_size, void* d_ws, size_t ws_size, hipStream_t stream) {
    static int grid = 0;
    if (grid == 0) {
        if (n_in != 40 || ws_size < WS_END) { fprintf(stderr, "kernel_launch: expected 40 inputs and >= %zu bytes of workspace; got %d, %zu\n", (size_t)WS_END, n_in, ws_size); grid = -1; return; }
        int dev = 0, cus = 0, per_cu = 0;
        if (hipGetDevice(&dev) != hipSuccess || hipDeviceGetAttribute(&cus, hipDeviceAttributeMultiprocessorCount, dev) != hipSuccess) { grid = -1; return; }
        if (hipFuncSetAttribute((const void*)fwd_kernel, hipFuncAttributeMaxDynamicSharedMemorySize, LDS_BYTES) != hipSuccess) { fprintf(stderr, "kernel_launch: hipFuncSetAttribute failed\n"); grid = -1; return; }
        if (hipOccupancyMaxActiveBlocksPerMultiprocessor(&per_cu, (const void*)fwd_kernel, NW * 64, LDS_BYTES) != hipSuccess || per_cu < 1) fprintf(stderr, "kernel_launch: occupancy query reports %d\n", per_cu);
        (void)hipGetLastError();
        grid = cus;
    }
    if (grid < 0) return;
    (void)hipMemsetAsync((char*)d_ws + WS_CTL, 0, CTL_ZERO_BYTES, stream);
    Args a{};
    for (int i = 0; i < 40; ++i) a.in[i] = (const float*)d_in[i];
    a.out = (float*)d_out; a.ws = (unsigned char*)d_ws;
    hipLaunchKernelGGL(fwd_kernel, dim3(grid), dim3(NW * 64), LDS_BYTES, stream, a);
    const hipError_t le = hipPeekAtLastError();
    if (le != hipSuccess) fprintf(stderr, "kernel_launch: launch failed: %s\n", hipGetErrorName(le));
}
```
